# Optimizing an MI355X kernel written in HIP

```python
import jax, jax.numpy as jnp
from jax import lax
import numpy as np

D_MODEL = 1024
BATCH = 8
SEQ = 2048
DEPTH = 1

HEAD_DIM = 64
DIL_CONFIGS = ((128, 1), (512, 4), (2048, 16))
DIL_HEADS = 8
DIL_WIDTH = DIL_HEADS * HEAD_DIM
DIL_BLOCK = 64
NA_HEADS = 8
NA_WIDTH = NA_HEADS * HEAD_DIM
NA_ROWS_MAX = 8
NA_COLS = 16
GRID_W = 64
MEM_LEN = 256
MEM_HEADS = 4
MEM_HEAD_DIM = 128
MEM_WIDTH = MEM_HEADS * MEM_HEAD_DIM
ROPE_THETA = 500000.0
ROPE_DIM = HEAD_DIM // 4
N_BRANCH = 3
BRANCH_WIDTH = 512
EPS = 1e-6
NEG = -1e30

kernel_name = 'hybrid_dilated_neighbourhood_memory_block'


def _in_sizes():
    return ([DIL_WIDTH] * (3 * len(DIL_CONFIGS))
            + [NA_WIDTH] * 3
            + [MEM_WIDTH]
            + [BRANCH_WIDTH] * N_BRANCH
            + [N_BRANCH * D_MODEL])


def _rmsnorm(x, g):
    xf = x.astype(jnp.float32)
    y = xf * lax.rsqrt(jnp.mean(xf * xf, axis=-1, keepdims=True) + EPS)
    return (y * g.astype(jnp.float32)).astype(x.dtype)


def _heads(t, n_heads):
    b, s, w = t.shape
    return t.reshape(b, s, n_heads, w // n_heads).transpose(0, 2, 1, 3)


def _merge_heads(t):
    b, h, s, d = t.shape
    return t.transpose(0, 2, 1, 3).reshape(b, s, h * d)


def _rope_partial(t, pos):
    half = ROPE_DIM // 2
    inv = ROPE_THETA ** (-jnp.arange(half, dtype=jnp.float32) * 2.0 / ROPE_DIM)
    ang = pos[:, None] * inv[None, :]
    cos, sin = jnp.cos(ang), jnp.sin(ang)
    tf = t[..., :ROPE_DIM].astype(jnp.float32)
    t1, t2 = tf[..., :half], tf[..., half:]
    rot = jnp.concatenate([t1 * cos - t2 * sin, t2 * cos + t1 * sin], axis=-1).astype(t.dtype)
    return jnp.concatenate([rot, t[..., ROPE_DIM:]], axis=-1)


def _banded_attention(q, k, v, reach):
    n, L, hd = q.shape
    bq = DIL_BLOCK
    nb = -(-L // bq)
    lp = nb * bq
    qb = jnp.pad(q, ((0, 0), (0, lp - L), (0, 0))).reshape(n, nb, bq, hd)
    kpad = jnp.pad(k, ((0, 0), (bq, lp - L + bq), (0, 0)))
    vpad = jnp.pad(v, ((0, 0), (bq, lp - L + bq), (0, 0)))
    win = jnp.arange(nb)[:, None] * bq + jnp.arange(3 * bq)[None, :]
    kw = kpad[:, win]
    vw = vpad[:, win]
    kpos = win - bq
    qpos = jnp.arange(nb)[:, None] * bq + jnp.arange(bq)[None, :]
    valid = ((kpos[:, None, :] >= 0) & (kpos[:, None, :] < L)
             & (jnp.abs(qpos[:, :, None] - kpos[:, None, :]) <= reach))
    s = jnp.einsum('nbqd,nbkd->nbqk', qb, kw, preferred_element_type=jnp.float32) * (hd ** -0.5)
    s = jnp.where(valid[None], s, NEG)
    m = jnp.max(s, axis=-1, keepdims=True)
    p = jnp.exp(s - m)
    den = jnp.sum(p, axis=-1)
    out = jnp.einsum('nbqk,nbkd->nbqd', p, vw.astype(jnp.float32)) / den[..., None]
    lse = m[..., 0] + jnp.log(den)
    return out.reshape(n, lp, hd)[:, :L], lse.reshape(n, lp)[:, :L]


def _dilated_attention(q, k, v, dilation, reach):
    b, h, s, hd = q.shape
    mlen = s // dilation

    def fold(t):
        return t.reshape(b, h, mlen, dilation, hd).transpose(0, 1, 3, 2, 4).reshape(b * h * dilation, mlen, hd)

    out, lse = _banded_attention(fold(q), fold(k), fold(v), reach)
    out = out.reshape(b, h, dilation, mlen, hd).transpose(0, 1, 3, 2, 4).reshape(b, h, s, hd)
    lse = lse.reshape(b, h, dilation, mlen).transpose(0, 1, 3, 2).reshape(b, h, s)
    return out, lse


def _neighbourhood_attention(q, k, v, rpb):
    b, h, s, hd = q.shape
    rows = s // GRID_W
    kr = min(NA_ROWS_MAX, rows)
    q5 = q.reshape(b, h, rows, GRID_W, hd)
    k5 = k.reshape(b, h, rows, GRID_W, hd)
    v5 = v.reshape(b, h, rows, GRID_W, hd)
    r_ids = jnp.arange(rows)
    r_start = jnp.clip(r_ids - kr // 2, 0, rows - kr)
    row_idx = r_start[:, None] + jnp.arange(kr)[None, :]
    k_rows = k5[:, :, row_idx]
    v_rows = v5[:, :, row_idx]
    c_ids = jnp.arange(GRID_W)
    c_start = jnp.clip(c_ids - NA_COLS // 2, 0, GRID_W - NA_COLS)
    col_mask = (c_ids[None, :] >= c_start[:, None]) & (c_ids[None, :] < c_start[:, None] + NA_COLS)
    dr = row_idx - r_ids[:, None]
    dc = jnp.clip(c_ids[None, :] - c_ids[:, None], -(NA_COLS - 1), NA_COLS - 1)
    bias = rpb[:, dr + NA_ROWS_MAX - 1][..., dc + NA_COLS - 1]
    bias = bias.transpose(0, 1, 3, 2, 4).astype(jnp.float32)
    sc = jnp.einsum('bhrqd,bhrjkd->bhrqjk', q5, k_rows, preferred_element_type=jnp.float32) * (hd ** -0.5)
    sc = jnp.where(col_mask[:, None, :], sc + bias[None], NEG)
    p = jax.nn.softmax(sc, axis=(-2, -1))
    out = jnp.einsum('bhrqjk,bhrjkd->bhrqd', p, v_rows.astype(jnp.float32))
    return out.reshape(b, h, s, hd)


def _cross_attention(q, k, v):
    sc = jnp.einsum('bhqd,bhkd->bhqk', q, k, preferred_element_type=jnp.float32) * (q.shape[-1] ** -0.5)
    p = jax.nn.softmax(sc, axis=-1)
    return jnp.einsum('bhqk,bhkd->bhqd', p, v.astype(jnp.float32))


def setup_inputs(seed: int = 0) -> dict:
    key = jax.random.key(seed)
    ks = jax.random.split(key, 14)
    f32 = jnp.float32
    n_in = int(sum(_in_sizes()))

    def nrm(k, shape, scale):
        return jax.random.normal(k, shape, f32) * scale

    return {
        'x': nrm(ks[0], (BATCH, SEQ, D_MODEL), 1.0),
        'mem': nrm(ks[1], (BATCH, MEM_LEN, D_MODEL), 1.0),
        'pre_norm': 1.0 + nrm(ks[2], (DEPTH, D_MODEL), 0.05),
        'w_in': nrm(ks[3], (DEPTH, D_MODEL, n_in), D_MODEL ** -0.5),
        'merge_bias': nrm(ks[4], (DEPTH, N_BRANCH, D_MODEL), 0.1),
        'na_rpb': nrm(ks[5], (DEPTH, NA_HEADS, 2 * NA_ROWS_MAX - 1, 2 * NA_COLS - 1), 0.1),
        'mem_norm': 1.0 + nrm(ks[6], (DEPTH, D_MODEL), 0.05),
        'w_mem_kv': nrm(ks[7], (DEPTH, D_MODEL, 2 * MEM_WIDTH), D_MODEL ** -0.5),
        'w_branch_a': nrm(ks[8], (DEPTH, BRANCH_WIDTH, D_MODEL), BRANCH_WIDTH ** -0.5),
        'w_branch_b': nrm(ks[9], (DEPTH, BRANCH_WIDTH, D_MODEL), BRANCH_WIDTH ** -0.5),
        'w_branch_c': nrm(ks[10], (DEPTH, BRANCH_WIDTH, D_MODEL), BRANCH_WIDTH ** -0.5),
        'w_out': nrm(ks[11], (DEPTH, D_MODEL, D_MODEL), D_MODEL ** -0.5),
        'post_norm': 1.0 + nrm(ks[12], (DEPTH, D_MODEL), 0.05),
    }


def reference(x, mem, pre_norm, w_in, merge_bias, na_rpb, mem_norm, w_mem_kv,
              w_branch_a, w_branch_b, w_branch_c, w_out, post_norm):
    b, s, _ = x.shape
    pos = jnp.arange(s, dtype=jnp.float32)
    split_at = np.cumsum(_in_sizes())[:-1].tolist()
    n_dil = len(DIL_CONFIGS)
    off = 3 * n_dil
    for layer in range(DEPTH):
        h = _rmsnorm(x, pre_norm[layer])
        parts = jnp.split(h @ w_in[layer], split_at, axis=-1)

        outs, lses = [], []
        for g, (window, dilation) in enumerate(DIL_CONFIGS):
            q = _rope_partial(_heads(parts[3 * g], DIL_HEADS), pos)
            k = _rope_partial(_heads(parts[3 * g + 1], DIL_HEADS), pos)
            v = _heads(parts[3 * g + 2], DIL_HEADS)
            o, l = _dilated_attention(q, k, v, dilation, (window // 2) // dilation)
            outs.append(o)
            lses.append(l)
        wts = jax.nn.softmax(jnp.stack(lses, axis=0), axis=0)
        out_a = _merge_heads(jnp.sum(wts[..., None] * jnp.stack(outs, axis=0), axis=0).astype(x.dtype))

        out_b = _merge_heads(_neighbourhood_attention(
            _heads(parts[off], NA_HEADS), _heads(parts[off + 1], NA_HEADS),
            _heads(parts[off + 2], NA_HEADS), na_rpb[layer]).astype(x.dtype))

        kv_m = _rmsnorm(mem, mem_norm[layer]) @ w_mem_kv[layer]
        k_m, v_m = jnp.split(kv_m, 2, axis=-1)
        out_c = _merge_heads(_cross_attention(
            _heads(parts[off + 3], MEM_HEADS), _heads(k_m, MEM_HEADS),
            _heads(v_m, MEM_HEADS)).astype(x.dtype))

        g_a, g_b, g_c = parts[off + 4], parts[off + 5], parts[off + 6]
        gate_logits = parts[off + 7].reshape(b, s, N_BRANCH, D_MODEL) + merge_bias[layer]
        gates = jax.nn.sigmoid(gate_logits.astype(jnp.float32)).astype(x.dtype)
        y = (gates[:, :, 0] * ((out_a * jax.nn.silu(g_a)) @ w_branch_a[layer])
             + gates[:, :, 1] * ((out_b * jax.nn.silu(g_b)) @ w_branch_b[layer])
             + gates[:, :, 2] * ((out_c * jax.nn.silu(g_c)) @ w_branch_c[layer]))
        y = y @ w_out[layer]
        x = x + _rmsnorm(y, post_norm[layer])
    return x
```

```cpp
#include <hip/hip_runtime.h>
#include <cstdio>
#include <cstdint>

#ifndef MK_N_LAUNCHES
#define MK_N_LAUNCHES 8
#endif
constexpr int N_PHASES = 8;

constexpr int BATCH = 8, SEQ = 2048, DM = 1024, MTOK = BATCH * SEQ;
constexpr int MEMLEN = 256, MMEM = BATCH * MEMLEN;
constexpr int NIN = 11264;
constexpr int N1 = 5120, N2 = 6144;
constexpr int WA = 4608, WB = 1536, WC = 512, WU = 1536, WG = 3072;
constexpr float EPS = 1e-6f;
constexpr float LOG2E = 1.4426950408889634f;
constexpr float QS64 = 0.125f * LOG2E;
constexpr float QS128 = 0.08838834764831845f * LOG2E;

constexpr size_t MiB = 1u << 20;
constexpr size_t WS_CTL = 0, CTL_ZERO_BYTES = 1 * MiB;
constexpr size_t WS_ROPE = 1 * MiB;
constexpr size_t WS_WIN = 2 * MiB;
constexpr size_t WS_WKV = 24 * MiB;
constexpr size_t WS_WBR = 26 * MiB;
constexpr size_t WS_WOUT = 29 * MiB;
constexpr size_t WS_XN = 32 * MiB;
constexpr size_t WS_Y = 32 * MiB;
constexpr size_t WS_MEMN = 64 * MiB;
constexpr size_t WS_KVM = 68 * MiB;
constexpr size_t WS_QKVA = 72 * MiB;
constexpr size_t WS_QKVB = 72 * MiB;
constexpr size_t WS_QC = 120 * MiB;
constexpr size_t WS_MG = 136 * MiB;
constexpr size_t WS_END = 232 * MiB;

constexpr int CW_BAR = 4096;
constexpr int LDS_BYTES = 147456;
constexpr int MISC_OFF = 131072 + 320;

#define GAS __attribute__((address_space(1)))
#define LAS __attribute__((address_space(3)))
typedef unsigned short bf16_t;
typedef short bf16x8 __attribute__((ext_vector_type(8)));
typedef float f32x4 __attribute__((ext_vector_type(4)));
typedef float f32x16 __attribute__((ext_vector_type(16)));
typedef unsigned v4u __attribute__((ext_vector_type(4)));
typedef GAS unsigned gu32;
#define RLX_AGENT __ATOMIC_RELAXED, __HIP_MEMORY_SCOPE_AGENT
#define LDS_WAIT() asm volatile("s_waitcnt lgkmcnt(0)" ::: "memory")
__device__ __forceinline__ unsigned f2bf(float f) { unsigned u = __builtin_bit_cast(unsigned, f); return (u + 0x7fffu + ((u >> 16) & 1u)) >> 16; }
__device__ __forceinline__ unsigned pk2(float lo, float hi) { return f2bf(lo) | (f2bf(hi) << 16); }
__device__ __forceinline__ float bf2f(unsigned v) { return __builtin_bit_cast(float, v << 16); }
__device__ __forceinline__ float blo(unsigned w) { return __builtin_bit_cast(float, w << 16); }
__device__ __forceinline__ float bhi(unsigned w) { return __builtin_bit_cast(float, w & 0xffff0000u); }

#define XB_TMO      128
#define XB_XCNT(j)  (256  + 64 * (j))
#define XB_XSUB(j)  (1280 + 64 * (j))
#define XB_XGEN(j)  (2304 + 64 * (j))
#define XB_TOP      3328
#define XB_TOPGEN   3392
#define XCD_BAR_WORDS 3456
#define XB_SPIN_CAP (1u << 18)
__device__ __forceinline__ unsigned xb_ld(unsigned* p)              { return __hip_atomic_load(p, __ATOMIC_RELAXED, __HIP_MEMORY_SCOPE_AGENT); }
__device__ __forceinline__ unsigned xb_add(unsigned* p, unsigned v) { return __hip_atomic_fetch_add(p, v, __ATOMIC_RELAXED, __HIP_MEMORY_SCOPE_AGENT); }
__device__ __forceinline__ unsigned xb_xcc_id() { return (unsigned)__builtin_amdgcn_s_getreg((3 << 11) | 20) & 0xFu; }
#define XB_SPIN(cond, bar) do { unsigned _sp = 0; while (cond) { __builtin_amdgcn_s_sleep(1); \
    if ((++_sp & 255u) == 0u) { if (xb_ld(&(bar)[XB_TMO])) break; if (_sp > XB_SPIN_CAP) { atomicAdd(&(bar)[XB_TMO], 1u); break; } } } } while (0)
struct XcdBarrier { unsigned* bar; unsigned x; volatile LAS unsigned* st; };
__device__ __forceinline__ XcdBarrier xcd_barrier_post(unsigned* bar, volatile LAS unsigned* st) {
    XcdBarrier b; b.bar = bar; b.x = xb_xcc_id(); b.st = st;
    if (threadIdx.x == 0) (void)xb_add(&bar[XB_XCNT(b.x)], 1u);
    return b;
}
__device__ __forceinline__ void xcd_barrier_complete(unsigned* bar, unsigned x, unsigned& nloc, unsigned& nx) {
    const unsigned G = gridDim.x * gridDim.y * gridDim.z;
    unsigned sum, cnt, mine, sp = 0u;
    for (;;) {
        sum = 0u; cnt = 0u; mine = 0u;
#pragma unroll
        for (unsigned j = 0; j < 16; ++j) { const unsigned c = xb_ld(&bar[XB_XCNT(j)]); sum += c; cnt += (c > 0u) ? 1u : 0u; mine = (j == x) ? c : mine; }
        if (sum == G) break;
        __builtin_amdgcn_s_sleep(1);
        if ((++sp & 255u) == 0u) { if (xb_ld(&bar[XB_TMO])) break; if (sp > XB_SPIN_CAP) { atomicAdd(&bar[XB_TMO], 1u); break; } }
    }
    nloc = mine > 0u ? mine : 1u; nx = cnt > 0u ? cnt : 1u;
}
__device__ __forceinline__ void xcd_barrier(const XcdBarrier& b) {
    asm volatile("s_waitcnt vmcnt(0)" ::: "memory");
    __syncthreads();
    if (threadIdx.x == 0) {
        unsigned* bar = b.bar;
        __builtin_amdgcn_s_waitcnt(0);
        unsigned nloc = b.st[0], nx = b.st[1];
        if (nloc == 0u) { xcd_barrier_complete(bar, b.x, nloc, nx); b.st[0] = nloc; b.st[1] = nx; }
        const unsigned old = xb_add(&bar[XB_XSUB(b.x)], 1u);
        const unsigned gen = old / nloc;
        if (old + 1u == (gen + 1u) * nloc) {
            __builtin_amdgcn_fence(__ATOMIC_RELEASE, "agent");
            asm volatile("s_waitcnt vmcnt(0)" ::: "memory");
            const unsigned og = xb_add(&bar[XB_TOP], 1u);
            const unsigned tg = og / nx;
            if (og + 1u == (tg + 1u) * nx) xb_add(&bar[XB_TOPGEN], 1u);
            else XB_SPIN(xb_ld(&bar[XB_TOPGEN]) == tg, bar);
            __builtin_amdgcn_fence(__ATOMIC_ACQUIRE, "agent");
            xb_add(&bar[XB_XGEN(b.x)], 1u);
            asm volatile("s_waitcnt vmcnt(0)" ::: "memory");
        } else {
            XB_SPIN(xb_ld(&bar[XB_XGEN(b.x)]) == gen, bar);
            __builtin_amdgcn_fence(__ATOMIC_ACQUIRE, "agent");
            asm volatile("s_waitcnt vmcnt(0)" ::: "memory");
        }
    }
    __syncthreads();
}

struct Frame {
    LAS unsigned char* lds;
    int tid, lane, wave, vcu, G, gw, NGW;
    const float *x, *mem, *pre_norm, *w_in, *merge_bias, *na_rpb, *mem_norm, *w_mem_kv, *w_br0, *w_br1, *w_br2, *w_out, *post_norm;
    float* out;
    float* rope;
    bf16_t *Wt_in, *Wt_kv, *Wt_br, *Wt_out, *XN, *Y, *MEMN, *KVM, *QKVA, *QKVB, *QC, *MG, *U;
};

__device__ __forceinline__ float wave_sum(float v) {
#pragma unroll
    for (int o = 1; o < 64; o <<= 1) v += __shfl_xor(v, o);
    return v;
}

__device__ __forceinline__ void p0_transpose_item(const float* W, int ldw, int c0, int k0, const float* g, bf16_t* WT, int ldt, int n0, int kofs, LAS float* scr, int lane) {
#pragma unroll 8
    for (int i = 0; i < 32; ++i) { const int kk = 2 * i + (lane >> 5); float v = W[(size_t)(k0 + kk) * ldw + c0 + (lane & 31)]; if (g) v *= g[k0 + kk]; scr[kk * 33 + (lane & 31)] = v; }
    LDS_WAIT(); asm volatile("" ::: "memory");
    const int c = lane & 7;
#pragma unroll
    for (int j = 0; j < 4; ++j) { const int n = (lane >> 3) + 8 * j; const LAS float* s = scr + (8 * c) * 33 + n;
        v4u o; o.x = pk2(s[0 * 33], s[1 * 33]); o.y = pk2(s[2 * 33], s[3 * 33]); o.z = pk2(s[4 * 33], s[5 * 33]); o.w = pk2(s[6 * 33], s[7 * 33]);
        *(GAS v4u*)(WT + (size_t)(n0 + n) * ldt + kofs + k0 + 8 * c) = o; }
    LDS_WAIT(); asm volatile("" ::: "memory");
}
__device__ __forceinline__ int win_col(int np) {
    if (np < 4608) return np;
    if (np < 5120) return 6656 + (np - 4608);
    if (np < 6656) return 4608 + (np - 5120);
    if (np < 7168) return 6144 + (np - 6656);
    return np;
}
__device__ __forceinline__ void rms_row_to_bf16(const float* xrow, bf16_t* orow, int lane) {
    const GAS f32x4* xr = (const GAS f32x4*)xrow + lane;
    f32x4 v[4]; float s = 0.f;
#pragma unroll
    for (int j = 0; j < 4; ++j) { v[j] = xr[64 * j]; s += (v[j].x * v[j].x + v[j].y * v[j].y) + (v[j].z * v[j].z + v[j].w * v[j].w); }
    const float rstd = 1.f / sqrtf(wave_sum(s) * (1.f / DM) + EPS);
    GAS unsigned long long* o8 = (GAS unsigned long long*)orow + lane;
#pragma unroll
    for (int j = 0; j < 4; ++j) o8[64 * j] = (unsigned long long)pk2(v[j].x * rstd, v[j].y * rstd) | ((unsigned long long)pk2(v[j].z * rstd, v[j].w * rstd) << 32);
}
__device__ __forceinline__ void p0_prologue(Frame& F) {
    LAS float* scr = (LAS float*)(F.lds + F.wave * 16384);
    constexpr int I_IN = 16 * (NIN / 32), I_KV = 16 * 32, I_BR = 8 * 32, I_OUT = 16 * 32;
    constexpr int NITEMS = I_IN + I_KV + 3 * I_BR + I_OUT;
    for (int it = F.gw; it < NITEMS; it += F.NGW) {
        int r = it;
        if (r < I_IN) { const int kb = r / (NIN / 32), nb = r % (NIN / 32); p0_transpose_item(F.w_in, NIN, win_col(32 * nb), 64 * kb, F.pre_norm, F.Wt_in, DM, 32 * nb, 0, scr, F.lane); continue; } r -= I_IN;
        if (r < I_KV) { const int kb = r / 32, nb = r % 32; p0_transpose_item(F.w_mem_kv, 1024, 32 * nb, 64 * kb, F.mem_norm, F.Wt_kv, DM, 32 * nb, 0, scr, F.lane); continue; } r -= I_KV;
        if (r < I_BR) { const int kb = r / 32, nb = r % 32; p0_transpose_item(F.w_br0, 1024, 32 * nb, 64 * kb, nullptr, F.Wt_br, 1536, 32 * nb, 0, scr, F.lane); continue; } r -= I_BR;
        if (r < I_BR) { const int kb = r / 32, nb = r % 32; p0_transpose_item(F.w_br1, 1024, 32 * nb, 64 * kb, nullptr, F.Wt_br, 1536, 32 * nb, 512, scr, F.lane); continue; } r -= I_BR;
        if (r < I_BR) { const int kb = r / 32, nb = r % 32; p0_transpose_item(F.w_br2, 1024, 32 * nb, 64 * kb, nullptr, F.Wt_br, 1536, 32 * nb, 1024, scr, F.lane); continue; } r -= I_BR;
        { const int kb = r / 32, nb = r % 32; p0_transpose_item(F.w_out, 1024, 32 * nb, 64 * kb, nullptr, F.Wt_out, DM, 32 * nb, 0, scr, F.lane); }
    }
    for (int m = F.gw; m < MTOK + MMEM; m += F.NGW) {
        if (m < MTOK) rms_row_to_bf16(F.x + (size_t)m * DM, F.XN + (size_t)m * DM, F.lane);
        else rms_row_to_bf16(F.mem + (size_t)(m - MTOK) * DM, F.MEMN + (size_t)(m - MTOK) * DM, F.lane);
    }
    for (int e = F.gw * 64 + F.lane; e < SEQ * 8; e += F.NGW * 64) {
        const int pos = e >> 3, i = e & 7;
        const double inv = exp(-(double)i * 0.125 * 13.122363377404328);
        const double ang = (double)pos * inv;
        F.rope[2 * e] = (float)cos(ang); F.rope[2 * e + 1] = (float)sin(ang);
    }
}

template <class Epi>
__device__ __forceinline__ void simple_gemm(const bf16_t* A, int lda, const bf16_t* Bt, int ldb, int Mr, int Nc, int K, const Frame& F, const Epi& E) {
    const int ntn = Nc / 32, nt = (Mr / 32) * ntn;
    const int r = F.lane & 31, h = F.lane >> 5;
    for (int t = F.gw; t < nt; t += F.NGW) {
        const int tm = t / ntn, tn = t % ntn;
        const bf16_t* ap = A + (size_t)(tm * 32 + r) * lda + 8 * h;
        const bf16_t* bp = Bt + (size_t)(tn * 32 + r) * ldb + 8 * h;
        f32x16 acc = {};
#pragma unroll 4
        for (int k = 0; k < K; k += 16) {
            const bf16x8 a = *(const bf16x8*)(ap + k), b = *(const bf16x8*)(bp + k);
            acc = __builtin_amdgcn_mfma_f32_32x32x16_bf16(a, b, acc, 0, 0, 0);
        }
#pragma unroll
        for (int i = 0; i < 16; ++i) E(tm * 32 + (i & 3) + 8 * (i >> 2) + 4 * h, tn * 32 + r, acc[i]);
    }
}
__device__ __forceinline__ float silu_f(float v) { return v / (1.f + __expf(-v)); }
__device__ __forceinline__ float sigm_f(float v) { return 1.f / (1.f + __expf(-v)); }

struct EpiIn {
    bf16_t *QKVA, *U, *QKVB, *QC, *MG; const float *rope, *merge_bias; int nofs;
    __device__ __forceinline__ void operator()(int row, int colr, float v) const {
        const int np = colr + nofs;
        const float partner = __shfl_xor(v, 8);
        if (np < 4608) {
            const int part = np >> 9, d = np & 63, kind = part % 3;
            if (kind != 2 && d < 16) {
                const int pos = row & (SEQ - 1); const float* cs = rope + ((pos << 3) + (d & 7)) * 2; const float c = cs[0], s = cs[1];
                v = (d < 8) ? (v * c - partner * s) : (v * c + partner * s);
            }
            if (kind == 0) v *= QS64;
            QKVA[(size_t)row * WA + np] = (bf16_t)f2bf(v);
        } else if (np < 5120) {
            U[(size_t)row * WU + (np - 4608)] = (bf16_t)f2bf(silu_f(v));
        } else if (np < 6656) {
            const int j = np - 5120; if (j < 512) v *= QS64;
            QKVB[(size_t)row * WB + j] = (bf16_t)f2bf(v);
        } else if (np < 7168) {
            QC[(size_t)row * WC + (np - 6656)] = (bf16_t)f2bf(v * QS128);
        } else if (np < 8192) {
            U[(size_t)row * WU + 512 + (np - 7168)] = (bf16_t)f2bf(silu_f(v));
        } else {
            const int j = np - 8192;
            MG[(size_t)row * WG + j] = (bf16_t)f2bf(sigm_f(v + merge_bias[j]));
        }
    }
};
struct EpiKv { bf16_t* KVM; __device__ __forceinline__ void operator()(int row, int col, float v) const { KVM[(size_t)row * DM + col] = (bf16_t)f2bf(v); } };
struct EpiF32 { float* O; __device__ __forceinline__ void operator()(int row, int col, float v) const { O[(size_t)row * DM + col] = v; } };

__device__ __forceinline__ void p3_simple(const Frame& F) {
    const int ntn = DM / 32, nt = (MTOK / 32) * ntn;
    const int r = F.lane & 31, h = F.lane >> 5;
    for (int t = F.gw; t < nt; t += F.NGW) {
        const int tm = t / ntn, tn = t % ntn;
        f32x16 y = {};
#pragma unroll 1
        for (int br = 0; br < 3; ++br) {
            const bf16_t* ap = F.U + (size_t)(tm * 32 + r) * WU + br * 512 + 8 * h;
            const bf16_t* bp = F.Wt_br + (size_t)(tn * 32 + r) * 1536 + br * 512 + 8 * h;
            f32x16 acc = {};
#pragma unroll 4
            for (int k = 0; k < 512; k += 16) {
                const bf16x8 a = *(const bf16x8*)(ap + k), b = *(const bf16x8*)(bp + k);
                acc = __builtin_amdgcn_mfma_f32_32x32x16_bf16(a, b, acc, 0, 0, 0);
            }
#pragma unroll
            for (int i = 0; i < 16; ++i) { const int row = tm * 32 + (i & 3) + 8 * (i >> 2) + 4 * h; y[i] += bf2f(F.MG[(size_t)row * WG + br * 1024 + tn * 32 + r]) * acc[i]; }
        }
#pragma unroll
        for (int i = 0; i < 16; ++i) { const int row = tm * 32 + (i & 3) + 8 * (i >> 2) + 4 * h; F.Y[(size_t)row * DM + tn * 32 + r] = (bf16_t)f2bf(y[i]); }
    }
}

__device__ __forceinline__ void ld64(const bf16_t* p, float (&q)[64]) {
#pragma unroll
    for (int c = 0; c < 8; ++c) { const v4u w = *(const v4u*)(p + 8 * c);
        q[8 * c + 0] = blo(w.x); q[8 * c + 1] = bhi(w.x); q[8 * c + 2] = blo(w.y); q[8 * c + 3] = bhi(w.y);
        q[8 * c + 4] = blo(w.z); q[8 * c + 5] = bhi(w.z); q[8 * c + 6] = blo(w.w); q[8 * c + 7] = bhi(w.w); }
}
__device__ __forceinline__ float dot64(const bf16_t* p, const float (&q)[64]) {
    float s0 = 0.f, s1 = 0.f;
#pragma unroll
    for (int c = 0; c < 8; ++c) { const v4u w = *(const v4u*)(p + 8 * c);
        s0 += q[8 * c + 0] * blo(w.x); s1 += q[8 * c + 1] * bhi(w.x); s0 += q[8 * c + 2] * blo(w.y); s1 += q[8 * c + 3] * bhi(w.y);
        s0 += q[8 * c + 4] * blo(w.z); s1 += q[8 * c + 5] * bhi(w.z); s0 += q[8 * c + 6] * blo(w.w); s1 += q[8 * c + 7] * bhi(w.w); }
    return s0 + s1;
}
__device__ __forceinline__ void axpy64(const bf16_t* p, float a, float (&o)[64]) {
#pragma unroll
    for (int c = 0; c < 8; ++c) { const v4u w = *(const v4u*)(p + 8 * c);
        o[8 * c + 0] += a * blo(w.x); o[8 * c + 1] += a * bhi(w.x); o[8 * c + 2] += a * blo(w.y); o[8 * c + 3] += a * bhi(w.y);
        o[8 * c + 4] += a * blo(w.z); o[8 * c + 5] += a * bhi(w.z); o[8 * c + 6] += a * blo(w.w); o[8 * c + 7] += a * bhi(w.w); }
}
#define ONLINE_STEP(sc, vptr) do { if ((sc) > mx) { const float f_ = exp2f(mx - (sc)); l *= f_; _Pragma("unroll") for (int d_ = 0; d_ < 64; ++d_) o[d_] *= f_; mx = (sc); } \
    const float p_ = exp2f((sc) - mx); l += p_; axpy64((vptr), p_, o); } while (0)
__device__ __forceinline__ void gate_store64(bf16_t* up, const float (&o)[64], float inv) {
#pragma unroll
    for (int c = 0; c < 8; ++c) { const v4u w = *(const v4u*)(up + 8 * c); v4u r;
        r.x = pk2(o[8 * c + 0] * inv * blo(w.x), o[8 * c + 1] * inv * bhi(w.x)); r.y = pk2(o[8 * c + 2] * inv * blo(w.y), o[8 * c + 3] * inv * bhi(w.y));
        r.z = pk2(o[8 * c + 4] * inv * blo(w.z), o[8 * c + 5] * inv * bhi(w.z)); r.w = pk2(o[8 * c + 6] * inv * blo(w.w), o[8 * c + 7] * inv * bhi(w.w));
        *(v4u*)(up + 8 * c) = r; }
}
__device__ __forceinline__ void attn_a_naive(const Frame& F) {
    for (int idx = F.vcu * 512 + F.tid; idx < MTOK * 8; idx += F.G * 512) {
        const int tok = idx >> 3, h = idx & 7, b = tok >> 11, s = tok & (SEQ - 1);
        float o[64]; float mx = -1e30f, l = 0.f;
#pragma unroll
        for (int d = 0; d < 64; ++d) o[d] = 0.f;
#pragma unroll 1
        for (int g = 0; g < 3; ++g) {
            const int dil = (g == 0) ? 1 : (g == 1 ? 4 : 16), mlen = SEQ / dil, m = s / dil, r = s % dil;
            float q[64]; ld64(F.QKVA + (size_t)tok * WA + (3 * g) * 512 + h * 64, q);
            const int j0 = (m - 64 > 0) ? m - 64 : 0, j1 = (m + 64 < mlen - 1) ? m + 64 : mlen - 1;
            for (int j = j0; j <= j1; ++j) {
                const size_t kt = (size_t)(b * SEQ + j * dil + r) * WA + h * 64;
                const float sc = dot64(F.QKVA + kt + (3 * g + 1) * 512, q);
                ONLINE_STEP(sc, F.QKVA + kt + (3 * g + 2) * 512);
            }
        }
        gate_store64(F.U + (size_t)tok * WU + h * 64, o, 1.f / l);
    }
}
__device__ __forceinline__ void attn_b_naive(const Frame& F) {
    for (int idx = F.vcu * 512 + F.tid; idx < MTOK * 8; idx += F.G * 512) {
        const int tok = idx >> 3, h = idx & 7, b = tok >> 11, s = tok & (SEQ - 1), r = s >> 6, c = s & 63;
        const int rs = (r - 4 < 0) ? 0 : (r - 4 > 24 ? 24 : r - 4), cs = (c - 8 < 0) ? 0 : (c - 8 > 48 ? 48 : c - 8);
        float o[64]; float mx = -1e30f, l = 0.f;
#pragma unroll
        for (int d = 0; d < 64; ++d) o[d] = 0.f;
        float q[64]; ld64(F.QKVB + (size_t)tok * WB + h * 64, q);
        for (int kr = 0; kr < 8; ++kr)
            for (int kc = 0; kc < 16; ++kc) {
                const size_t kt = (size_t)(b * SEQ + (rs + kr) * 64 + cs + kc) * WB + h * 64;
                const float bias = F.na_rpb[(h * 15 + (rs + kr - r + 7)) * 31 + (cs + kc - c + 15)] * LOG2E;
                const float sc = dot64(F.QKVB + kt + 512, q) + bias;
                ONLINE_STEP(sc, F.QKVB + kt + 1024);
            }
        gate_store64(F.U + (size_t)tok * WU + 512 + h * 64, o, 1.f / l);
    }
}
__device__ __forceinline__ void attn_c_naive(const Frame& F) {
    for (int idx = F.vcu * 512 + F.tid; idx < MTOK * 8; idx += F.G * 512) {
        const int tok = idx >> 3, h = (idx >> 1) & 3, half = idx & 1, b = tok >> 11;
        float o[64]; float mx = -1e30f, l = 0.f;
#pragma unroll
        for (int d = 0; d < 64; ++d) o[d] = 0.f;
        float q[64]; ld64(F.QC + (size_t)tok * WC + h * 128 + half * 64, q);
        for (int j = 0; j < MEMLEN; ++j) {
            const size_t kt = (size_t)(b * MEMLEN + j) * DM + h * 128 + half * 64;
            float sc = dot64(F.KVM + kt, q); sc += __shfl_xor(sc, 1);
            ONLINE_STEP(sc, F.KVM + kt + 512);
        }
        gate_store64(F.U + (size_t)tok * WU + 1024 + h * 128 + half * 64, o, 1.f / l);
    }
}

__device__ __forceinline__ void p5_rows(const Frame& F) {
    for (int m = F.gw; m < MTOK; m += F.NGW) {
        GAS f32x4* zr = (GAS f32x4*)(F.out + (size_t)m * DM) + F.lane; const GAS f32x4* xr = (const GAS f32x4*)(F.x + (size_t)m * DM) + F.lane; const GAS f32x4* pn = (const GAS f32x4*)F.post_norm + F.lane;
        f32x4 v[4]; float s = 0.f;
#pragma unroll
        for (int j = 0; j < 4; ++j) { v[j] = zr[64 * j]; s += (v[j].x * v[j].x + v[j].y * v[j].y) + (v[j].z * v[j].z + v[j].w * v[j].w); }
        const float rstd = 1.f / sqrtf(wave_sum(s) * (1.f / DM) + EPS);
#pragma unroll
        for (int j = 0; j < 4; ++j) zr[64 * j] = xr[64 * j] + v[j] * rstd * pn[64 * j];
    }
}

struct Args { const float* in[13]; float* out; unsigned char* ws; int ph_lo, ph_hi, li, pad; };
__global__ void __launch_bounds__(512, 2) fwd_kernel(Args args) {
    extern __shared__ __attribute__((aligned(16))) unsigned char lds[];
    Frame F;
    F.lds = (LAS unsigned char*)lds;
    F.tid = threadIdx.x; F.lane = F.tid & 63; F.wave = __builtin_amdgcn_readfirstlane(F.tid >> 6);
    F.G = gridDim.x; { const int bx = blockIdx.x; F.vcu = (F.G % 8 == 0) ? (bx % 8) * (F.G / 8) + bx / 8 : bx; }
    F.gw = F.vcu * 8 + F.wave; F.NGW = F.G * 8;
    unsigned char* ws = args.ws;
    F.x = args.in[0]; F.mem = args.in[1]; F.pre_norm = args.in[2]; F.w_in = args.in[3]; F.merge_bias = args.in[4]; F.na_rpb = args.in[5]; F.mem_norm = args.in[6];
    F.w_mem_kv = args.in[7]; F.w_br0 = args.in[8]; F.w_br1 = args.in[9]; F.w_br2 = args.in[10]; F.w_out = args.in[11]; F.post_norm = args.in[12];
    F.out = args.out; F.rope = (float*)(ws + WS_ROPE);
    F.Wt_in = (bf16_t*)(ws + WS_WIN); F.Wt_kv = (bf16_t*)(ws + WS_WKV); F.Wt_br = (bf16_t*)(ws + WS_WBR); F.Wt_out = (bf16_t*)(ws + WS_WOUT);
    F.XN = (bf16_t*)(ws + WS_XN); F.Y = (bf16_t*)(ws + WS_Y); F.MEMN = (bf16_t*)(ws + WS_MEMN); F.KVM = (bf16_t*)(ws + WS_KVM);
    F.QKVA = (bf16_t*)(ws + WS_QKVA); F.QKVB = (bf16_t*)(ws + WS_QKVB); F.QC = (bf16_t*)(ws + WS_QC); F.MG = (bf16_t*)(ws + WS_MG); F.U = (bf16_t*)args.out;
    volatile LAS unsigned* MISC = (volatile LAS unsigned*)(F.lds + MISC_OFF);
    for (int u = F.tid; u < (LDS_BYTES - 131072) / 4; u += 512) ((LAS unsigned*)(F.lds + 131072))[u] = 0u;
    __syncthreads();
    XcdBarrier bar; bar.bar = (unsigned*)(ws + WS_CTL) + CW_BAR; bar.x = 0; bar.st = nullptr;
    if (MK_N_LAUNCHES == 1) bar = xcd_barrier_post((unsigned*)(ws + WS_CTL) + CW_BAR, MISC + 8);
    const int lo = args.ph_lo, hi = args.ph_hi;
#define IN(k) (lo <= (k) && (k) < hi)
#define SEAM(k) do { if (IN(k) && IN((k) + 1)) xcd_barrier(bar); } while (0)

    if (IN(0)) { p0_prologue(F); } SEAM(0);
    if (IN(1)) { EpiIn E{F.QKVA, F.U, F.QKVB, F.QC, F.MG, F.rope, F.merge_bias, 0}; simple_gemm(F.XN, DM, F.Wt_in, DM, MTOK, N1, DM, F, E);
                 EpiKv Ek{F.KVM}; simple_gemm(F.MEMN, DM, F.Wt_kv, DM, MMEM, DM, DM, F, Ek); } SEAM(1);
    if (IN(2)) { attn_a_naive(F); } SEAM(2);
    if (IN(3)) { EpiIn E{F.QKVA, F.U, F.QKVB, F.QC, F.MG, F.rope, F.merge_bias, N1}; simple_gemm(F.XN, DM, F.Wt_in + (size_t)N1 * DM, DM, MTOK, N2, DM, F, E); } SEAM(3);
    if (IN(4)) { attn_b_naive(F); attn_c_naive(F); } SEAM(4);
    if (IN(5)) { p3_simple(F); } SEAM(5);
    if (IN(6)) { EpiF32 E{F.out}; simple_gemm(F.Y, DM, F.Wt_out, DM, MTOK, DM, DM, F, E); } SEAM(6);
    if (IN(7)) { p5_rows(F); }
#undef IN
#undef SEAM
}

extern "C" void kernel_launch(void* const* d_in, const int* in_sizes, int n_in, void* d_out, int out_size, void* d_ws, size_t ws_size, hipStream_t stream) {
    static int grid = 0;
    if (grid == 0) {
        if (n_in != 13 || in_sizes[0] != MTOK * DM || out_size != MTOK * DM || ws_size < WS_END) { fprintf(stderr, "kernel_launch: unexpected shapes / workspace (n_in %d, ws %zu)\n", n_in, ws_size); grid = -1; return; }
        int dev = 0, cus = 0;
        if (hipGetDevice(&dev) != hipSuccess || hipDeviceGetAttribute(&cus, hipDeviceAttributeMultiprocessorCount, dev) != hipSuccess) { grid = -1; return; }
        if (hipFuncSetAttribute((const void*)fwd_kernel, hipFuncAttributeMaxDynamicSharedMemorySize, LDS_BYTES) != hipSuccess) { fprintf(stderr, "kernel_launch: hipFuncSetAttribute failed\n"); grid = -1; return; }
        (void)hipGetLastError();
        grid = cus;
    }
    if (grid < 0) return;
    (void)hipMemsetAsync((char*)d_ws + WS_CTL, 0, CTL_ZERO_BYTES, stream);
    Args a{};
    for (int i = 0; i < 13; ++i) a.in[i] = (const float*)d_in[i];
    a.out = (float*)d_out; a.ws = (unsigned char*)d_ws;
    for (int li = 0; li < MK_N_LAUNCHES; ++li) {
        if (MK_N_LAUNCHES == 1) { a.ph_lo = 0; a.ph_hi = N_PHASES; } else { a.ph_lo = li; a.ph_hi = li + 1; }
        a.li = li;
        hipLaunchKernelGGL(fwd_kernel, dim3(grid), dim3(512), LDS_BYTES, stream, a);
    }
}
```

```cpp
#include <hip/hip_runtime.h>
#include <cstdio>
#include <cstdint>

#ifndef MK_N_LAUNCHES
#define MK_N_LAUNCHES 1
#endif
constexpr int N_PHASES = 8;

constexpr int BATCH = 8, SEQ = 2048, DM = 1024, MTOK = BATCH * SEQ;
constexpr int MEMLEN = 256, MMEM = BATCH * MEMLEN;
constexpr int NIN = 11264;
constexpr int N1 = 5120, N2 = 6144;
constexpr int WA = 4608, WB = 1536, WC = 512, WU = 1536, WG = 3072;
constexpr float EPS = 1e-6f;
constexpr float LOG2E = 1.4426950408889634f;
constexpr float QS64 = 0.125f * LOG2E;
constexpr float QS128 = 0.08838834764831845f * LOG2E;

constexpr size_t MiB = 1u << 20;
constexpr size_t WS_CTL = 0, CTL_ZERO_BYTES = 1 * MiB;
constexpr size_t WS_ROPE = 1 * MiB;
constexpr size_t WS_WIN = 2 * MiB;
constexpr size_t WS_WKV = 24 * MiB;
constexpr size_t WS_WBR = 26 * MiB;
constexpr size_t WS_WOUT = 29 * MiB;
constexpr size_t WS_XN = 32 * MiB;
constexpr size_t WS_Y = 32 * MiB;
constexpr size_t WS_MEMN = 64 * MiB;
constexpr size_t WS_KVM = 68 * MiB;
constexpr size_t WS_QKVA = 72 * MiB;
constexpr size_t WS_QKVB = 72 * MiB;
constexpr size_t WS_QC = 120 * MiB;
constexpr size_t WS_MG = 136 * MiB;
constexpr size_t WS_END = 232 * MiB;

constexpr int CW_BAR = 4096;
constexpr int LDS_BYTES = 147456;
constexpr int MISC_OFF = 131072 + 320;

#define GAS __attribute__((address_space(1)))
#define LAS __attribute__((address_space(3)))
typedef unsigned short bf16_t;
typedef short bf16x8 __attribute__((ext_vector_type(8)));
typedef float f32x4 __attribute__((ext_vector_type(4)));
typedef float f32x16 __attribute__((ext_vector_type(16)));
typedef unsigned v4u __attribute__((ext_vector_type(4)));
typedef GAS unsigned gu32;
#define RLX_AGENT __ATOMIC_RELAXED, __HIP_MEMORY_SCOPE_AGENT
#define LDS_WAIT() asm volatile("s_waitcnt lgkmcnt(0)" ::: "memory")
__device__ __forceinline__ unsigned f2bf(float f) { unsigned u = __builtin_bit_cast(unsigned, f); return (u + 0x7fffu + ((u >> 16) & 1u)) >> 16; }
__device__ __forceinline__ unsigned pk2(float lo, float hi) { return f2bf(lo) | (f2bf(hi) << 16); }
__device__ __forceinline__ float bf2f(unsigned v) { return __builtin_bit_cast(float, v << 16); }
__device__ __forceinline__ float blo(unsigned w) { return __builtin_bit_cast(float, w << 16); }
__device__ __forceinline__ float bhi(unsigned w) { return __builtin_bit_cast(float, w & 0xffff0000u); }

#define XB_TMO      128
#define XB_XCNT(j)  (256  + 64 * (j))
#define XB_XSUB(j)  (1280 + 64 * (j))
#define XB_XGEN(j)  (2304 + 64 * (j))
#define XB_TOP      3328
#define XB_TOPGEN   3392
#define XCD_BAR_WORDS 3456
#define XB_SPIN_CAP (1u << 18)
__device__ __forceinline__ unsigned xb_ld(unsigned* p)              { return __hip_atomic_load(p, __ATOMIC_RELAXED, __HIP_MEMORY_SCOPE_AGENT); }
__device__ __forceinline__ unsigned xb_add(unsigned* p, unsigned v) { return __hip_atomic_fetch_add(p, v, __ATOMIC_RELAXED, __HIP_MEMORY_SCOPE_AGENT); }
__device__ __forceinline__ unsigned xb_xcc_id() { return (unsigned)__builtin_amdgcn_s_getreg((3 << 11) | 20) & 0xFu; }
#define XB_SPIN(cond, bar) do { unsigned _sp = 0; while (cond) { __builtin_amdgcn_s_sleep(1); \
    if ((++_sp & 255u) == 0u) { if (xb_ld(&(bar)[XB_TMO])) break; if (_sp > XB_SPIN_CAP) { atomicAdd(&(bar)[XB_TMO], 1u); break; } } } } while (0)
struct XcdBarrier { unsigned* bar; unsigned x; volatile LAS unsigned* st; };
__device__ __forceinline__ XcdBarrier xcd_barrier_post(unsigned* bar, volatile LAS unsigned* st) {
    XcdBarrier b; b.bar = bar; b.x = xb_xcc_id(); b.st = st;
    if (threadIdx.x == 0) (void)xb_add(&bar[XB_XCNT(b.x)], 1u);
    return b;
}
__device__ __forceinline__ void xcd_barrier_complete(unsigned* bar, unsigned x, unsigned& nloc, unsigned& nx) {
    const unsigned G = gridDim.x * gridDim.y * gridDim.z;
    unsigned sum, cnt, mine, sp = 0u;
    for (;;) {
        sum = 0u; cnt = 0u; mine = 0u;
#pragma unroll
        for (unsigned j = 0; j < 16; ++j) { const unsigned c = xb_ld(&bar[XB_XCNT(j)]); sum += c; cnt += (c > 0u) ? 1u : 0u; mine = (j == x) ? c : mine; }
        if (sum == G) break;
        __builtin_amdgcn_s_sleep(1);
        if ((++sp & 255u) == 0u) { if (xb_ld(&bar[XB_TMO])) break; if (sp > XB_SPIN_CAP) { atomicAdd(&bar[XB_TMO], 1u); break; } }
    }
    nloc = mine > 0u ? mine : 1u; nx = cnt > 0u ? cnt : 1u;
}
__device__ __forceinline__ void xcd_barrier(const XcdBarrier& b) {
    asm volatile("s_waitcnt vmcnt(0)" ::: "memory");
    __syncthreads();
    if (threadIdx.x == 0) {
        unsigned* bar = b.bar;
        __builtin_amdgcn_s_waitcnt(0);
        unsigned nloc = b.st[0], nx = b.st[1];
        if (nloc == 0u) { xcd_barrier_complete(bar, b.x, nloc, nx); b.st[0] = nloc; b.st[1] = nx; }
        const unsigned old = xb_add(&bar[XB_XSUB(b.x)], 1u);
        const unsigned gen = old / nloc;
        if (old + 1u == (gen + 1u) * nloc) {
            __builtin_amdgcn_fence(__ATOMIC_RELEASE, "agent");
            asm volatile("s_waitcnt vmcnt(0)" ::: "memory");
            const unsigned og = xb_add(&bar[XB_TOP], 1u);
            const unsigned tg = og / nx;
            if (og + 1u == (tg + 1u) * nx) xb_add(&bar[XB_TOPGEN], 1u);
            else XB_SPIN(xb_ld(&bar[XB_TOPGEN]) == tg, bar);
            __builtin_amdgcn_fence(__ATOMIC_ACQUIRE, "agent");
            xb_add(&bar[XB_XGEN(b.x)], 1u);
            asm volatile("s_waitcnt vmcnt(0)" ::: "memory");
        } else {
            XB_SPIN(xb_ld(&bar[XB_XGEN(b.x)]) == gen, bar);
            __builtin_amdgcn_fence(__ATOMIC_ACQUIRE, "agent");
            asm volatile("s_waitcnt vmcnt(0)" ::: "memory");
        }
    }
    __syncthreads();
}

struct Frame {
    LAS unsigned char* lds;
    int tid, lane, wave, vcu, G, gw, NGW;
    const float *x, *mem, *pre_norm, *w_in, *merge_bias, *na_rpb, *mem_norm, *w_mem_kv, *w_br0, *w_br1, *w_br2, *w_out, *post_norm;
    float* out;
    float* rope;
    bf16_t *Wt_in, *Wt_kv, *Wt_br, *Wt_out, *XN, *Y, *MEMN, *KVM, *QKVA, *QKVB, *QC, *MG, *U;
};

__device__ __forceinline__ float wave_sum(float v) {
#pragma unroll
    for (int o = 1; o < 64; o <<= 1) v += __shfl_xor(v, o);
    return v;
}

__device__ __forceinline__ void p0_transpose_item(const float* W, int ldw, int c0, int k0, const float* g, bf16_t* WT, int ldt, int n0, int kofs, LAS float* scr, int lane) {
#pragma unroll 8
    for (int i = 0; i < 32; ++i) { const int kk = 2 * i + (lane >> 5); float v = W[(size_t)(k0 + kk) * ldw + c0 + (lane & 31)]; if (g) v *= g[k0 + kk]; scr[kk * 33 + (lane & 31)] = v; }
    LDS_WAIT(); asm volatile("" ::: "memory");
    const int c = lane & 7;
#pragma unroll
    for (int j = 0; j < 4; ++j) { const int n = (lane >> 3) + 8 * j; const LAS float* s = scr + (8 * c) * 33 + n;
        v4u o; o.x = pk2(s[0 * 33], s[1 * 33]); o.y = pk2(s[2 * 33], s[3 * 33]); o.z = pk2(s[4 * 33], s[5 * 33]); o.w = pk2(s[6 * 33], s[7 * 33]);
        *(GAS v4u*)(WT + (size_t)(n0 + n) * ldt + kofs + k0 + 8 * c) = o; }
    LDS_WAIT(); asm volatile("" ::: "memory");
}
__device__ __forceinline__ int win_col(int np) {
    if (np < 4608) return np;
    if (np < 5120) return 6656 + (np - 4608);
    if (np < 6656) return 4608 + (np - 5120);
    if (np < 7168) return 6144 + (np - 6656);
    return np;
}
__device__ __forceinline__ void rms_row_to_bf16(const float* xrow, bf16_t* orow, int lane) {
    const GAS f32x4* xr = (const GAS f32x4*)xrow + lane;
    f32x4 v[4]; float s = 0.f;
#pragma unroll
    for (int j = 0; j < 4; ++j) { v[j] = xr[64 * j]; s += (v[j].x * v[j].x + v[j].y * v[j].y) + (v[j].z * v[j].z + v[j].w * v[j].w); }
    const float rstd = 1.f / sqrtf(wave_sum(s) * (1.f / DM) + EPS);
    GAS unsigned long long* o8 = (GAS unsigned long long*)orow + lane;
#pragma unroll
    for (int j = 0; j < 4; ++j) o8[64 * j] = (unsigned long long)pk2(v[j].x * rstd, v[j].y * rstd) | ((unsigned long long)pk2(v[j].z * rstd, v[j].w * rstd) << 32);
}
__device__ __forceinline__ void p0_prologue(Frame& F) {
    LAS float* scr = (LAS float*)(F.lds + F.wave * 16384);
    constexpr int I_IN = 16 * (NIN / 32), I_KV = 16 * 32, I_BR = 8 * 32, I_OUT = 16 * 32;
    constexpr int NITEMS = I_IN + I_KV + 3 * I_BR + I_OUT;
    for (int it = F.gw; it < NITEMS; it += F.NGW) {
        int r = it;
        if (r < I_IN) { const int kb = r / (NIN / 32), nb = r % (NIN / 32); p0_transpose_item(F.w_in, NIN, win_col(32 * nb), 64 * kb, F.pre_norm, F.Wt_in, DM, 32 * nb, 0, scr, F.lane); continue; } r -= I_IN;
        if (r < I_KV) { const int kb = r / 32, nb = r % 32; p0_transpose_item(F.w_mem_kv, 1024, 32 * nb, 64 * kb, F.mem_norm, F.Wt_kv, DM, 32 * nb, 0, scr, F.lane); continue; } r -= I_KV;
        if (r < I_BR) { const int kb = r / 32, nb = r % 32; p0_transpose_item(F.w_br0, 1024, 32 * nb, 64 * kb, nullptr, F.Wt_br, 1536, 32 * nb, 0, scr, F.lane); continue; } r -= I_BR;
        if (r < I_BR) { const int kb = r / 32, nb = r % 32; p0_transpose_item(F.w_br1, 1024, 32 * nb, 64 * kb, nullptr, F.Wt_br, 1536, 32 * nb, 512, scr, F.lane); continue; } r -= I_BR;
        if (r < I_BR) { const int kb = r / 32, nb = r % 32; p0_transpose_item(F.w_br2, 1024, 32 * nb, 64 * kb, nullptr, F.Wt_br, 1536, 32 * nb, 1024, scr, F.lane); continue; } r -= I_BR;
        { const int kb = r / 32, nb = r % 32; p0_transpose_item(F.w_out, 1024, 32 * nb, 64 * kb, nullptr, F.Wt_out, DM, 32 * nb, 0, scr, F.lane); }
    }
    for (int m = F.gw; m < MTOK + MMEM; m += F.NGW) {
        if (m < MTOK) rms_row_to_bf16(F.x + (size_t)m * DM, F.XN + (size_t)m * DM, F.lane);
        else rms_row_to_bf16(F.mem + (size_t)(m - MTOK) * DM, F.MEMN + (size_t)(m - MTOK) * DM, F.lane);
    }
    for (int e = F.gw * 64 + F.lane; e < SEQ * 8; e += F.NGW * 64) {
        const int pos = e >> 3, i = e & 7;
        const double inv = exp(-(double)i * 0.125 * 13.122363377404328);
        const double ang = (double)pos * inv;
        F.rope[2 * e] = (float)cos(ang); F.rope[2 * e + 1] = (float)sin(ang);
    }
}

template <class Epi>
__device__ __forceinline__ void simple_gemm(const bf16_t* A, int lda, const bf16_t* Bt, int ldb, int Mr, int Nc, int K, const Frame& F, const Epi& E) {
    const int ntn = Nc / 32, nt = (Mr / 32) * ntn;
    const int r = F.lane & 31, h = F.lane >> 5;
    for (int t = F.gw; t < nt; t += F.NGW) {
        const int tm = t / ntn, tn = t % ntn;
        const bf16_t* ap = A + (size_t)(tm * 32 + r) * lda + 8 * h;
        const bf16_t* bp = Bt + (size_t)(tn * 32 + r) * ldb + 8 * h;
        f32x16 acc = {};
#pragma unroll 4
        for (int k = 0; k < K; k += 16) {
            const bf16x8 a = *(const bf16x8*)(ap + k), b = *(const bf16x8*)(bp + k);
            acc = __builtin_amdgcn_mfma_f32_32x32x16_bf16(a, b, acc, 0, 0, 0);
        }
#pragma unroll
        for (int i = 0; i < 16; ++i) E(tm * 32 + (i & 3) + 8 * (i >> 2) + 4 * h, tn * 32 + r, acc[i]);
    }
}
__device__ __forceinline__ float silu_f(float v) { return v / (1.f + __expf(-v)); }
__device__ __forceinline__ float sigm_f(float v) { return 1.f / (1.f + __expf(-v)); }

struct EpiIn {
    bf16_t *QKVA, *U, *QKVB, *QC, *MG; const float *rope, *merge_bias; int nofs;
    __device__ __forceinline__ void operator()(int row, int colr, float v) const {
        const int np = colr + nofs;
        const float partner = __shfl_xor(v, 8);
        if (np < 4608) {
            const int part = np >> 9, d = np & 63, kind = part % 3;
            if (kind != 2 && d < 16) {
                const int pos = row & (SEQ - 1); const float* cs = rope + ((pos << 3) + (d & 7)) * 2; const float c = cs[0], s = cs[1];
                v = (d < 8) ? (v * c - partner * s) : (v * c + partner * s);
            }
            if (kind == 0) v *= QS64;
            QKVA[(size_t)row * WA + np] = (bf16_t)f2bf(v);
        } else if (np < 5120) {
            U[(size_t)row * WU + (np - 4608)] = (bf16_t)f2bf(silu_f(v));
        } else if (np < 6656) {
            const int j = np - 5120; if (j < 512) v *= QS64;
            QKVB[(size_t)row * WB + j] = (bf16_t)f2bf(v);
        } else if (np < 7168) {
            QC[(size_t)row * WC + (np - 6656)] = (bf16_t)f2bf(v * QS128);
        } else if (np < 8192) {
            U[(size_t)row * WU + 512 + (np - 7168)] = (bf16_t)f2bf(silu_f(v));
        } else {
            const int j = np - 8192;
            MG[(size_t)row * WG + j] = (bf16_t)f2bf(sigm_f(v + merge_bias[j]));
        }
    }
};
struct EpiKv { bf16_t* KVM; __device__ __forceinline__ void operator()(int row, int col, float v) const { KVM[(size_t)row * DM + col] = (bf16_t)f2bf(v); } };
struct EpiF32 { float* O; __device__ __forceinline__ void operator()(int row, int col, float v) const { O[(size_t)row * DM + col] = v; } };

__device__ __forceinline__ void p3_simple(const Frame& F) {
    const int ntn = DM / 32, nt = (MTOK / 32) * ntn;
    const int r = F.lane & 31, h = F.lane >> 5;
    for (int t = F.gw; t < nt; t += F.NGW) {
        const int tm = t / ntn, tn = t % ntn;
        f32x16 y = {};
#pragma unroll 1
        for (int br = 0; br < 3; ++br) {
            const bf16_t* ap = F.U + (size_t)(tm * 32 + r) * WU + br * 512 + 8 * h;
            const bf16_t* bp = F.Wt_br + (size_t)(tn * 32 + r) * 1536 + br * 512 + 8 * h;
            f32x16 acc = {};
#pragma unroll 4
            for (int k = 0; k < 512; k += 16) {
                const bf16x8 a = *(const bf16x8*)(ap + k), b = *(const bf16x8*)(bp + k);
                acc = __builtin_amdgcn_mfma_f32_32x32x16_bf16(a, b, acc, 0, 0, 0);
            }
#pragma unroll
            for (int i = 0; i < 16; ++i) { const int row = tm * 32 + (i & 3) + 8 * (i >> 2) + 4 * h; y[i] += bf2f(F.MG[(size_t)row * WG + br * 1024 + tn * 32 + r]) * acc[i]; }
        }
#pragma unroll
        for (int i = 0; i < 16; ++i) { const int row = tm * 32 + (i & 3) + 8 * (i >> 2) + 4 * h; F.Y[(size_t)row * DM + tn * 32 + r] = (bf16_t)f2bf(y[i]); }
    }
}

__device__ __forceinline__ void ld64(const bf16_t* p, float (&q)[64]) {
#pragma unroll
    for (int c = 0; c < 8; ++c) { const v4u w = *(const v4u*)(p + 8 * c);
        q[8 * c + 0] = blo(w.x); q[8 * c + 1] = bhi(w.x); q[8 * c + 2] = blo(w.y); q[8 * c + 3] = bhi(w.y);
        q[8 * c + 4] = blo(w.z); q[8 * c + 5] = bhi(w.z); q[8 * c + 6] = blo(w.w); q[8 * c + 7] = bhi(w.w); }
}
__device__ __forceinline__ float dot64(const bf16_t* p, const float (&q)[64]) {
    float s0 = 0.f, s1 = 0.f;
#pragma unroll
    for (int c = 0; c < 8; ++c) { const v4u w = *(const v4u*)(p + 8 * c);
        s0 += q[8 * c + 0] * blo(w.x); s1 += q[8 * c + 1] * bhi(w.x); s0 += q[8 * c + 2] * blo(w.y); s1 += q[8 * c + 3] * bhi(w.y);
        s0 += q[8 * c + 4] * blo(w.z); s1 += q[8 * c + 5] * bhi(w.z); s0 += q[8 * c + 6] * blo(w.w); s1 += q[8 * c + 7] * bhi(w.w); }
    return s0 + s1;
}
__device__ __forceinline__ void axpy64(const bf16_t* p, float a, float (&o)[64]) {
#pragma unroll
    for (int c = 0; c < 8; ++c) { const v4u w = *(const v4u*)(p + 8 * c);
        o[8 * c + 0] += a * blo(w.x); o[8 * c + 1] += a * bhi(w.x); o[8 * c + 2] += a * blo(w.y); o[8 * c + 3] += a * bhi(w.y);
        o[8 * c + 4] += a * blo(w.z); o[8 * c + 5] += a * bhi(w.z); o[8 * c + 6] += a * blo(w.w); o[8 * c + 7] += a * bhi(w.w); }
}
#define ONLINE_STEP(sc, vptr) do { if ((sc) > mx) { const float f_ = exp2f(mx - (sc)); l *= f_; _Pragma("unroll") for (int d_ = 0; d_ < 64; ++d_) o[d_] *= f_; mx = (sc); } \
    const float p_ = exp2f((sc) - mx); l += p_; axpy64((vptr), p_, o); } while (0)
__device__ __forceinline__ void gate_store64(bf16_t* up, const float (&o)[64], float inv) {
#pragma unroll
    for (int c = 0; c < 8; ++c) { const v4u w = *(const v4u*)(up + 8 * c); v4u r;
        r.x = pk2(o[8 * c + 0] * inv * blo(w.x), o[8 * c + 1] * inv * bhi(w.x)); r.y = pk2(o[8 * c + 2] * inv * blo(w.y), o[8 * c + 3] * inv * bhi(w.y));
        r.z = pk2(o[8 * c + 4] * inv * blo(w.z), o[8 * c + 5] * inv * bhi(w.z)); r.w = pk2(o[8 * c + 6] * inv * blo(w.w), o[8 * c + 7] * inv * bhi(w.w));
        *(v4u*)(up + 8 * c) = r; }
}
__device__ __forceinline__ void attn_a_naive(const Frame& F) {
    for (int idx = F.vcu * 512 + F.tid; idx < MTOK * 8; idx += F.G * 512) {
        const int tok = idx >> 3, h = idx & 7, b = tok >> 11, s = tok & (SEQ - 1);
        float o[64]; float mx = -1e30f, l = 0.f;
#pragma unroll
        for (int d = 0; d < 64; ++d) o[d] = 0.f;
#pragma unroll 1
        for (int g = 0; g < 3; ++g) {
            const int dil = (g == 0) ? 1 : (g == 1 ? 4 : 16), mlen = SEQ / dil, m = s / dil, r = s % dil;
            float q[64]; ld64(F.QKVA + (size_t)tok * WA + (3 * g) * 512 + h * 64, q);
            const int j0 = (m - 64 > 0) ? m - 64 : 0, j1 = (m + 64 < mlen - 1) ? m + 64 : mlen - 1;
            for (int j = j0; j <= j1; ++j) {
                const size_t kt = (size_t)(b * SEQ + j * dil + r) * WA + h * 64;
                const float sc = dot64(F.QKVA + kt + (3 * g + 1) * 512, q);
                ONLINE_STEP(sc, F.QKVA + kt + (3 * g + 2) * 512);
            }
        }
        gate_store64(F.U + (size_t)tok * WU + h * 64, o, 1.f / l);
    }
}
__device__ __forceinline__ void attn_b_naive(const Frame& F) {
    for (int idx = F.vcu * 512 + F.tid; idx < MTOK * 8; idx += F.G * 512) {
        const int tok = idx >> 3, h = idx & 7, b = tok >> 11, s = tok & (SEQ - 1), r = s >> 6, c = s & 63;
        const int rs = (r - 4 < 0) ? 0 : (r - 4 > 24 ? 24 : r - 4), cs = (c - 8 < 0) ? 0 : (c - 8 > 48 ? 48 : c - 8);
        float o[64]; float mx = -1e30f, l = 0.f;
#pragma unroll
        for (int d = 0; d < 64; ++d) o[d] = 0.f;
        float q[64]; ld64(F.QKVB + (size_t)tok * WB + h * 64, q);
        for (int kr = 0; kr < 8; ++kr)
            for (int kc = 0; kc < 16; ++kc) {
                const size_t kt = (size_t)(b * SEQ + (rs + kr) * 64 + cs + kc) * WB + h * 64;
                const float bias = F.na_rpb[(h * 15 + (rs + kr - r + 7)) * 31 + (cs + kc - c + 15)] * LOG2E;
                const float sc = dot64(F.QKVB + kt + 512, q) + bias;
                ONLINE_STEP(sc, F.QKVB + kt + 1024);
            }
        gate_store64(F.U + (size_t)tok * WU + 512 + h * 64, o, 1.f / l);
    }
}
__device__ __forceinline__ void attn_c_naive(const Frame& F) {
    for (int idx = F.vcu * 512 + F.tid; idx < MTOK * 8; idx += F.G * 512) {
        const int tok = idx >> 3, h = (idx >> 1) & 3, half = idx & 1, b = tok >> 11;
        float o[64]; float mx = -1e30f, l = 0.f;
#pragma unroll
        for (int d = 0; d < 64; ++d) o[d] = 0.f;
        float q[64]; ld64(F.QC + (size_t)tok * WC + h * 128 + half * 64, q);
        for (int j = 0; j < MEMLEN; ++j) {
            const size_t kt = (size_t)(b * MEMLEN + j) * DM + h * 128 + half * 64;
            float sc = dot64(F.KVM + kt, q); sc += __shfl_xor(sc, 1);
            ONLINE_STEP(sc, F.KVM + kt + 512);
        }
        gate_store64(F.U + (size_t)tok * WU + 1024 + h * 128 + half * 64, o, 1.f / l);
    }
}

__device__ __forceinline__ void p5_rows(const Frame& F) {
    for (int m = F.gw; m < MTOK; m += F.NGW) {
        GAS f32x4* zr = (GAS f32x4*)(F.out + (size_t)m * DM) + F.lane; const GAS f32x4* xr = (const GAS f32x4*)(F.x + (size_t)m * DM) + F.lane; const GAS f32x4* pn = (const GAS f32x4*)F.post_norm + F.lane;
        f32x4 v[4]; float s = 0.f;
#pragma unroll
        for (int j = 0; j < 4; ++j) { v[j] = zr[64 * j]; s += (v[j].x * v[j].x + v[j].y * v[j].y) + (v[j].z * v[j].z + v[j].w * v[j].w); }
        const float rstd = 1.f / sqrtf(wave_sum(s) * (1.f / DM) + EPS);
#pragma unroll
        for (int j = 0; j < 4; ++j) zr[64 * j] = xr[64 * j] + v[j] * rstd * pn[64 * j];
    }
}

struct Args { const float* in[13]; float* out; unsigned char* ws; int ph_lo, ph_hi, li, pad; };
__global__ void __launch_bounds__(512, 2) fwd_kernel(Args args) {
    extern __shared__ __attribute__((aligned(16))) unsigned char lds[];
    Frame F;
    F.lds = (LAS unsigned char*)lds;
    F.tid = threadIdx.x; F.lane = F.tid & 63; F.wave = __builtin_amdgcn_readfirstlane(F.tid >> 6);
    F.G = gridDim.x; { const int bx = blockIdx.x; F.vcu = (F.G % 8 == 0) ? (bx % 8) * (F.G / 8) + bx / 8 : bx; }
    F.gw = F.vcu * 8 + F.wave; F.NGW = F.G * 8;
    unsigned char* ws = args.ws;
    F.x = args.in[0]; F.mem = args.in[1]; F.pre_norm = args.in[2]; F.w_in = args.in[3]; F.merge_bias = args.in[4]; F.na_rpb = args.in[5]; F.mem_norm = args.in[6];
    F.w_mem_kv = args.in[7]; F.w_br0 = args.in[8]; F.w_br1 = args.in[9]; F.w_br2 = args.in[10]; F.w_out = args.in[11]; F.post_norm = args.in[12];
    F.out = args.out; F.rope = (float*)(ws + WS_ROPE);
    F.Wt_in = (bf16_t*)(ws + WS_WIN); F.Wt_kv = (bf16_t*)(ws + WS_WKV); F.Wt_br = (bf16_t*)(ws + WS_WBR); F.Wt_out = (bf16_t*)(ws + WS_WOUT);
    F.XN = (bf16_t*)(ws + WS_XN); F.Y = (bf16_t*)(ws + WS_Y); F.MEMN = (bf16_t*)(ws + WS_MEMN); F.KVM = (bf16_t*)(ws + WS_KVM);
    F.QKVA = (bf16_t*)(ws + WS_QKVA); F.QKVB = (bf16_t*)(ws + WS_QKVB); F.QC = (bf16_t*)(ws + WS_QC); F.MG = (bf16_t*)(ws + WS_MG); F.U = (bf16_t*)args.out;
    volatile LAS unsigned* MISC = (volatile LAS unsigned*)(F.lds + MISC_OFF);
    for (int u = F.tid; u < (LDS_BYTES - 131072) / 4; u += 512) ((LAS unsigned*)(F.lds + 131072))[u] = 0u;
    __syncthreads();
    XcdBarrier bar; bar.bar = (unsigned*)(ws + WS_CTL) + CW_BAR; bar.x = 0; bar.st = nullptr;
    if (MK_N_LAUNCHES == 1) bar = xcd_barrier_post((unsigned*)(ws + WS_CTL) + CW_BAR, MISC + 8);
    const int lo = args.ph_lo, hi = args.ph_hi;
#define IN(k) (lo <= (k) && (k) < hi)
#define SEAM(k) do { if (IN(k) && IN((k) + 1)) xcd_barrier(bar); } while (0)

    if (IN(0)) { p0_prologue(F); } SEAM(0);
    if (IN(1)) { EpiIn E{F.QKVA, F.U, F.QKVB, F.QC, F.MG, F.rope, F.merge_bias, 0}; simple_gemm(F.XN, DM, F.Wt_in, DM, MTOK, N1, DM, F, E);
                 EpiKv Ek{F.KVM}; simple_gemm(F.MEMN, DM, F.Wt_kv, DM, MMEM, DM, DM, F, Ek); } SEAM(1);
    if (IN(2)) { attn_a_naive(F); } SEAM(2);
    if (IN(3)) { EpiIn E{F.QKVA, F.U, F.QKVB, F.QC, F.MG, F.rope, F.merge_bias, N1}; simple_gemm(F.XN, DM, F.Wt_in + (size_t)N1 * DM, DM, MTOK, N2, DM, F, E); } SEAM(3);
    if (IN(4)) { attn_b_naive(F); attn_c_naive(F); } SEAM(4);
    if (IN(5)) { p3_simple(F); } SEAM(5);
    if (IN(6)) { EpiF32 E{F.out}; simple_gemm(F.Y, DM, F.Wt_out, DM, MTOK, DM, DM, F, E); } SEAM(6);
    if (IN(7)) { p5_rows(F); }
#undef IN
#undef SEAM
}

extern "C" void kernel_launch(void* const* d_in, const int* in_sizes, int n_in, void* d_out, int out_size, void* d_ws, size_t ws_size, hipStream_t stream) {
    static int grid = 0;
    if (grid == 0) {
        if (n_in != 13 || in_sizes[0] != MTOK * DM || out_size != MTOK * DM || ws_size < WS_END) { fprintf(stderr, "kernel_launch: unexpected shapes / workspace (n_in %d, ws %zu)\n", n_in, ws_size); grid = -1; return; }
        int dev = 0, cus = 0;
        if (hipGetDevice(&dev) != hipSuccess || hipDeviceGetAttribute(&cus, hipDeviceAttributeMultiprocessorCount, dev) != hipSuccess) { grid = -1; return; }
        if (hipFuncSetAttribute((const void*)fwd_kernel, hipFuncAttributeMaxDynamicSharedMemorySize, LDS_BYTES) != hipSuccess) { fprintf(stderr, "kernel_launch: hipFuncSetAttribute failed\n"); grid = -1; return; }
        (void)hipGetLastError();
        grid = cus;
    }
    if (grid < 0) return;
    (void)hipMemsetAsync((char*)d_ws + WS_CTL, 0, CTL_ZERO_BYTES, stream);
    Args a{};
    for (int i = 0; i < 13; ++i) a.in[i] = (const float*)d_in[i];
    a.out = (float*)d_out; a.ws = (unsigned char*)d_ws;
    for (int li = 0; li < MK_N_LAUNCHES; ++li) {
        if (MK_N_LAUNCHES == 1) { a.ph_lo = 0; a.ph_hi = N_PHASES; } else { a.ph_lo = li; a.ph_hi = li + 1; }
        a.li = li;
        hipLaunchKernelGGL(fwd_kernel, dim3(grid), dim3(512), LDS_BYTES, stream, a);
    }
}
```

```cpp
#include <hip/hip_runtime.h>
#include <cstdio>
#include <cstdint>

#ifndef MK_N_LAUNCHES
#define MK_N_LAUNCHES 1
#endif
constexpr int N_PHASES = 8;

constexpr int BATCH = 8, SEQ = 2048, DM = 1024, MTOK = BATCH * SEQ;
constexpr int MEMLEN = 256, MMEM = BATCH * MEMLEN;
constexpr int NIN = 11264;
constexpr int N1 = 5120, N2 = 6144;
constexpr int WA = 4608, WB = 1536, WC = 512, WU = 1536, WG = 3072;
constexpr float EPS = 1e-6f;
constexpr float LOG2E = 1.4426950408889634f;
constexpr float QS64 = 0.125f * LOG2E;
constexpr float QS128 = 0.08838834764831845f * LOG2E;

constexpr size_t MiB = 1u << 20;
constexpr size_t WS_CTL = 0, CTL_ZERO_BYTES = 1 * MiB;
constexpr size_t WS_ROPE = 1 * MiB;
constexpr size_t WS_WIN = 2 * MiB;
constexpr size_t WS_WKV = 24 * MiB;
constexpr size_t WS_WBR = 26 * MiB;
constexpr size_t WS_WOUT = 29 * MiB;
constexpr size_t WS_XN = 32 * MiB;
constexpr size_t WS_Y = 32 * MiB;
constexpr size_t WS_MEMN = 64 * MiB;
constexpr size_t WS_KVM = 68 * MiB;
constexpr size_t WS_QKVA = 72 * MiB;
constexpr size_t WS_QKVB = 72 * MiB;
constexpr size_t WS_QC = 120 * MiB;
constexpr size_t WS_MG = 136 * MiB;
constexpr size_t WS_LSE = 232 * MiB;
constexpr size_t WS_END = 234 * MiB;

constexpr int CW_BAR = 4096;
constexpr int LDS_BYTES = 147456;
constexpr int MISC_OFF = 131072 + 320;

#define GAS __attribute__((address_space(1)))
#define LAS __attribute__((address_space(3)))
typedef unsigned short bf16_t;
typedef short bf16x8 __attribute__((ext_vector_type(8)));
typedef float f32x4 __attribute__((ext_vector_type(4)));
typedef float f32x16 __attribute__((ext_vector_type(16)));
typedef unsigned v4u __attribute__((ext_vector_type(4)));
typedef GAS unsigned gu32;
#define RLX_AGENT __ATOMIC_RELAXED, __HIP_MEMORY_SCOPE_AGENT
#define LDS_WAIT() asm volatile("s_waitcnt lgkmcnt(0)" ::: "memory")
__device__ __forceinline__ unsigned f2bf(float f) { unsigned u = __builtin_bit_cast(unsigned, f); return (u + 0x7fffu + ((u >> 16) & 1u)) >> 16; }
__device__ __forceinline__ unsigned pk2(float lo, float hi) { return f2bf(lo) | (f2bf(hi) << 16); }
__device__ __forceinline__ float bf2f(unsigned v) { return __builtin_bit_cast(float, v << 16); }
__device__ __forceinline__ float blo(unsigned w) { return __builtin_bit_cast(float, w << 16); }
__device__ __forceinline__ float bhi(unsigned w) { return __builtin_bit_cast(float, w & 0xffff0000u); }

#define XB_TMO      128
#define XB_XCNT(j)  (256  + 64 * (j))
#define XB_XSUB(j)  (1280 + 64 * (j))
#define XB_XGEN(j)  (2304 + 64 * (j))
#define XB_TOP      3328
#define XB_TOPGEN   3392
#define XCD_BAR_WORDS 3456
#define XB_SPIN_CAP (1u << 18)
__device__ __forceinline__ unsigned xb_ld(unsigned* p)              { return __hip_atomic_load(p, __ATOMIC_RELAXED, __HIP_MEMORY_SCOPE_AGENT); }
__device__ __forceinline__ unsigned xb_add(unsigned* p, unsigned v) { return __hip_atomic_fetch_add(p, v, __ATOMIC_RELAXED, __HIP_MEMORY_SCOPE_AGENT); }
__device__ __forceinline__ unsigned xb_xcc_id() { return (unsigned)__builtin_amdgcn_s_getreg((3 << 11) | 20) & 0xFu; }
#define XB_SPIN(cond, bar) do { unsigned _sp = 0; while (cond) { __builtin_amdgcn_s_sleep(1); \
    if ((++_sp & 255u) == 0u) { if (xb_ld(&(bar)[XB_TMO])) break; if (_sp > XB_SPIN_CAP) { atomicAdd(&(bar)[XB_TMO], 1u); break; } } } } while (0)
struct XcdBarrier { unsigned* bar; unsigned x; volatile LAS unsigned* st; };
__device__ __forceinline__ XcdBarrier xcd_barrier_post(unsigned* bar, volatile LAS unsigned* st) {
    XcdBarrier b; b.bar = bar; b.x = xb_xcc_id(); b.st = st;
    if (threadIdx.x == 0) (void)xb_add(&bar[XB_XCNT(b.x)], 1u);
    return b;
}
__device__ __forceinline__ void xcd_barrier_complete(unsigned* bar, unsigned x, unsigned& nloc, unsigned& nx) {
    const unsigned G = gridDim.x * gridDim.y * gridDim.z;
    unsigned sum, cnt, mine, sp = 0u;
    for (;;) {
        sum = 0u; cnt = 0u; mine = 0u;
#pragma unroll
        for (unsigned j = 0; j < 16; ++j) { const unsigned c = xb_ld(&bar[XB_XCNT(j)]); sum += c; cnt += (c > 0u) ? 1u : 0u; mine = (j == x) ? c : mine; }
        if (sum == G) break;
        __builtin_amdgcn_s_sleep(1);
        if ((++sp & 255u) == 0u) { if (xb_ld(&bar[XB_TMO])) break; if (sp > XB_SPIN_CAP) { atomicAdd(&bar[XB_TMO], 1u); break; } }
    }
    nloc = mine > 0u ? mine : 1u; nx = cnt > 0u ? cnt : 1u;
}
__device__ __forceinline__ void xcd_barrier(const XcdBarrier& b) {
    asm volatile("s_waitcnt vmcnt(0)" ::: "memory");
    __syncthreads();
    if (threadIdx.x == 0) {
        unsigned* bar = b.bar;
        __builtin_amdgcn_s_waitcnt(0);
        unsigned nloc = b.st[0], nx = b.st[1];
        if (nloc == 0u) { xcd_barrier_complete(bar, b.x, nloc, nx); b.st[0] = nloc; b.st[1] = nx; }
        const unsigned old = xb_add(&bar[XB_XSUB(b.x)], 1u);
        const unsigned gen = old / nloc;
        if (old + 1u == (gen + 1u) * nloc) {
            __builtin_amdgcn_fence(__ATOMIC_RELEASE, "agent");
            asm volatile("s_waitcnt vmcnt(0)" ::: "memory");
            const unsigned og = xb_add(&bar[XB_TOP], 1u);
            const unsigned tg = og / nx;
            if (og + 1u == (tg + 1u) * nx) xb_add(&bar[XB_TOPGEN], 1u);
            else XB_SPIN(xb_ld(&bar[XB_TOPGEN]) == tg, bar);
            __builtin_amdgcn_fence(__ATOMIC_ACQUIRE, "agent");
            xb_add(&bar[XB_XGEN(b.x)], 1u);
            asm volatile("s_waitcnt vmcnt(0)" ::: "memory");
        } else {
            XB_SPIN(xb_ld(&bar[XB_XGEN(b.x)]) == gen, bar);
            __builtin_amdgcn_fence(__ATOMIC_ACQUIRE, "agent");
            asm volatile("s_waitcnt vmcnt(0)" ::: "memory");
        }
    }
    __syncthreads();
}

namespace pg8 {
#define PG8_LAS __attribute__((address_space(3)))
typedef unsigned short bf16_t;
typedef short bf16x8 __attribute__((ext_vector_type(8)));
typedef float f32x4 __attribute__((ext_vector_type(4)));
typedef unsigned u32x4 __attribute__((ext_vector_type(4)));
constexpr int BM = 256, BK = 64, HALF = 128, HTB = HALF * BK * 2  , STAGE_BYTES = 8 * HTB, NXCD = 8, WGM = 8;

__host__ __device__ __forceinline__ int lds_byte(int r, int c) { const int st = (r >> 4) * 2 + (c >> 5), rr = r & 15, cc = c & 31, ob = rr * 64 + cc * 2; return st * 1024 + (ob ^ (((ob >> 9) & 1) << 5)); }
__host__ __device__ __forceinline__ void stage_rc(int b, int& R, int& C) { const int st = b / 1024, sb = b % 1024, swz = sb ^ (((sb >> 9) & 1) << 5); R = (st >> 1) * 16 + swz / 64; C = (st & 1) * 32 + (swz % 64) / 2; }
__host__ __device__ __forceinline__ int perm32(int rho) { const int n = rho >> 4, i = rho & 15; return 8 * (i >> 2) + 4 * n + (i & 3); }

struct Unit { int pm, pn; };
struct Gemm { const bf16_t* A; const bf16_t* Bt; int M, N, K; };

struct StaticOrder {
    int nM, nN, nwg, G, c;
    __host__ __device__ void init(int M, int N, int G_, int c_) { nM = M / BM; nN = N / BM; nwg = nM * nN; G = G_; c = c_; }
    __host__ __device__ bool next(int i, Unit& u) const {
        const long L = (long)i * G + c; if (L >= nwg) return false;
        int wgid = (int)L; { const int q = nwg / NXCD, r = nwg % NXCD, xcd = wgid % NXCD, off = wgid / NXCD; wgid = (xcd < r ? xcd * (q + 1) : r * (q + 1) + (xcd - r) * q) + off; }
        const int nig = WGM * nN, gid = wgid / nig, fm = gid * WGM, gsz = (nM - fm) < WGM ? (nM - fm) : WGM;
        u.pm = fm + ((wgid % nig) % gsz); u.pn = (wgid % nig) / gsz; return true;
    }
    __device__ __forceinline__ void a_ready(const Unit&) const {}
    __device__ __forceinline__ void done(const Unit&) const {}
};

template <class Epi, class Sched, class Hook, bool ALIGN_EPI = false, bool SP2 = false>
__device__ __forceinline__ void gemm_phase(PG8_LAS unsigned char* lds, const Gemm g, const Sched& S, const Epi& E, const Hook& H) {
    const int tid = threadIdx.x, wid = __builtin_amdgcn_readfirstlane(tid >> 6), lane = tid & 63, wr = wid >> 2, wc = wid & 3, fr = lane & 15, fq = lane >> 4;
    const int K = g.K, nt = K / BK;
    unsigned voffA[2], voffB[2];
#pragma unroll
    for (int i = 0; i < 2; ++i) { int R, C; stage_rc(tid * 16 + i * 8192, R, C); const int Rb = Epi::PERM ? ((R & ~31) + perm32(R & 31)) : R;
        voffA[i] = (unsigned)(R * K + C) * 2u; voffB[i] = (unsigned)(Rb * K + C) * 2u; }
    const size_t kstep = (size_t)(BK * 2);
    const size_t hstep = (size_t)HALF * K * 2;
    const size_t tstep = 2 * hstep;
    const unsigned ldsw = (unsigned)wid * 1024u;
    const int aoff = lds_byte(wr * 64 + fr, fq * 8), boff = lds_byte(wc * 32 + fr, fq * 8);
#define PG8_SA(b, h) (((b) * 2 + (h)) * HTB)
#define PG8_SB(b, h) ((4 + (b) * 2 + (h)) * HTB)
#define PG8_STAGE(bufoff, gbase, voff) do { _Pragma("unroll") for (int _i = 0; _i < 2; ++_i) \
        __builtin_amdgcn_global_load_lds((const unsigned*)((const char*)(gbase) + (voff)[_i]), (PG8_LAS unsigned*)(lds + (bufoff) + ldsw + _i * 8192), 16, 0, 0); } while (0)
#define PG8_LDA(dst, b, h) do { _Pragma("unroll") for (int m = 0; m < 4; ++m) _Pragma("unroll") for (int k = 0; k < 2; ++k) dst[m][k] = *(const PG8_LAS bf16x8*)(lds + PG8_SA(b, h) + aoff + m * 2048 + k * 1024); } while (0)
#define PG8_LDB(dst, b, h) do { _Pragma("unroll") for (int n = 0; n < 2; ++n) _Pragma("unroll") for (int k = 0; k < 2; ++k) dst[n][k] = *(const PG8_LAS bf16x8*)(lds + PG8_SB(b, h) + boff + n * 2048 + k * 1024); } while (0)
#define PG8_MMA(ai, bj, At, Bt) do { __builtin_amdgcn_s_setprio(1); _Pragma("unroll") for (int m = 0; m < 4; ++m) _Pragma("unroll") for (int n = 0; n < 2; ++n) _Pragma("unroll") for (int k = 0; k < 2; ++k) \
        acc[ai][bj][m][n] = __builtin_amdgcn_mfma_f32_16x16x32_bf16(Bt[n][k], At[m][k], acc[ai][bj][m][n], 0, 0, 0); __builtin_amdgcn_s_setprio(0); } while (0)
#define PG8_WAIT_V(n) asm volatile("s_waitcnt vmcnt(" #n ")" ::: "memory")
#define PG8_WAIT_L(n) asm volatile("s_waitcnt lgkmcnt(" #n ")" ::: "memory")
#define PG8_BAR __builtin_amdgcn_s_barrier()
#define PG8_SCHED __builtin_amdgcn_sched_barrier(0)
    Unit cur, nxt; int ui = 0;
    if (!S.next(0, cur)) return;
    f32x4 acc[2][2][4][2];
#pragma unroll
    for (int a = 0; a < 2; ++a)
#pragma unroll
        for (int b = 0; b < 2; ++b)
#pragma unroll
            for (int m = 0; m < 4; ++m)
#pragma unroll
                for (int n = 0; n < 2; ++n) acc[a][b][m][n] = (f32x4){0.f, 0.f, 0.f, 0.f};
    bf16x8 At[4][2], B0[2][2], B1[2][2];
    const char* cA = (const char*)g.A + (size_t)cur.pm * tstep; const char* cB = (const char*)g.Bt + (size_t)cur.pn * tstep;
    S.a_ready(cur);
    if constexpr (SP2) {
        PG8_STAGE(PG8_SB(0, 0), cB, voffB); PG8_STAGE(PG8_SB(0, 1), cB + hstep, voffB); PG8_STAGE(PG8_SA(0, 0), cA, voffA); PG8_STAGE(PG8_SA(0, 1), cA + hstep, voffA);
        if (wr == 1) PG8_BAR;
        PG8_WAIT_V(2); PG8_BAR;
        PG8_STAGE(PG8_SB(1, 0), cB + kstep, voffB); PG8_STAGE(PG8_SA(1, 0), cA + kstep, voffA); PG8_STAGE(PG8_SB(1, 1), cB + hstep + kstep, voffB);
        PG8_WAIT_V(6); PG8_BAR;
    } else {
        PG8_STAGE(PG8_SB(0, 0), cB, voffB); PG8_STAGE(PG8_SA(0, 0), cA, voffA); PG8_STAGE(PG8_SB(0, 1), cB + hstep, voffB); PG8_STAGE(PG8_SA(0, 1), cA + hstep, voffA);
        if (wr == 1) PG8_BAR;
        PG8_WAIT_V(4); PG8_BAR;
        PG8_STAGE(PG8_SB(1, 0), cB + kstep, voffB); PG8_STAGE(PG8_SA(1, 0), cA + kstep, voffA); PG8_STAGE(PG8_SB(1, 1), cB + hstep + kstep, voffB);
        PG8_WAIT_V(6); PG8_BAR;
    }
    for (;;) {
        const bool has_next = S.next(ui + 1, nxt);
        const char* nA = has_next ? (const char*)g.A + (size_t)nxt.pm * tstep : cA; const char* nB = has_next ? (const char*)g.Bt + (size_t)nxt.pn * tstep : cB;
        for (int t = 0; t < nt; t += 2) {
            const bool last = (t == nt - 2);
            H.at(t, acc, cur, wr, wc, fr, fq);
            const char* a1 = cA + (size_t)(t + 1) * kstep;
            const char* a2 = last ? nA : cA + (size_t)(t + 2) * kstep; const char* b2 = last ? nB : cB + (size_t)(t + 2) * kstep;
            const char* a3 = a2 + kstep; const char* b3 = b2 + kstep;
            if (last && has_next) S.a_ready(nxt);
            if constexpr (SP2) {
            PG8_LDB(B0, 0, 0); PG8_LDB(B1, 0, 1); PG8_SCHED; PG8_LDA(At, 0, 0); PG8_STAGE(PG8_SA(1, 1), a1 + hstep, voffA);
            PG8_WAIT_V(8); PG8_WAIT_L(0); PG8_BAR; PG8_MMA(0, 0, At, B0); PG8_MMA(0, 1, At, B1); PG8_BAR; PG8_SCHED;
            PG8_LDA(At, 0, 1); PG8_STAGE(PG8_SB(0, 0), b2, voffB); PG8_STAGE(PG8_SB(0, 1), b2 + hstep, voffB); PG8_STAGE(PG8_SA(0, 0), a2, voffA);
            PG8_WAIT_V(8); PG8_WAIT_L(0); PG8_BAR; PG8_MMA(1, 0, At, B0); PG8_MMA(1, 1, At, B1); PG8_BAR; PG8_SCHED;
            PG8_LDB(B0, 1, 0); PG8_LDB(B1, 1, 1); PG8_SCHED; PG8_LDA(At, 1, 0); PG8_STAGE(PG8_SA(0, 1), a2 + hstep, voffA);
            PG8_WAIT_V(8); PG8_WAIT_L(0); PG8_BAR; PG8_MMA(0, 0, At, B0); PG8_MMA(0, 1, At, B1); PG8_BAR; PG8_SCHED;
            PG8_LDA(At, 1, 1); PG8_STAGE(PG8_SB(1, 0), b3, voffB); PG8_STAGE(PG8_SB(1, 1), b3 + hstep, voffB); PG8_STAGE(PG8_SA(1, 0), a3, voffA);
            PG8_WAIT_V(8); PG8_WAIT_L(0); PG8_BAR; PG8_MMA(1, 0, At, B0); PG8_MMA(1, 1, At, B1); PG8_BAR; PG8_SCHED;
            } else {
            PG8_LDB(B0, 0, 0); PG8_SCHED; PG8_LDA(At, 0, 0); PG8_STAGE(PG8_SA(1, 1), a1 + hstep, voffA);
            PG8_WAIT_L(8); PG8_BAR; PG8_WAIT_L(0); PG8_MMA(0, 0, At, B0); PG8_BAR; PG8_SCHED;
            PG8_LDB(B1, 0, 1); PG8_STAGE(PG8_SB(0, 0), b2, voffB);
            PG8_BAR; PG8_WAIT_L(0); PG8_MMA(0, 1, At, B1); PG8_BAR;
            PG8_LDA(At, 0, 1); PG8_STAGE(PG8_SA(0, 0), a2, voffA);
            PG8_BAR; PG8_WAIT_L(0); PG8_MMA(1, 0, At, B0); PG8_BAR; PG8_SCHED;
            PG8_STAGE(PG8_SB(0, 1), b2 + hstep, voffB);
            PG8_WAIT_V(6); PG8_BAR; PG8_MMA(1, 1, At, B1); PG8_BAR;
            PG8_LDB(B0, 1, 0); PG8_SCHED; PG8_LDA(At, 1, 0); PG8_STAGE(PG8_SA(0, 1), a2 + hstep, voffA);
            PG8_WAIT_L(8); PG8_BAR; PG8_WAIT_L(0); PG8_MMA(0, 0, At, B0); PG8_BAR; PG8_SCHED;
            PG8_LDB(B1, 1, 1); PG8_STAGE(PG8_SB(1, 0), b3, voffB);
            PG8_BAR; PG8_WAIT_L(0); PG8_MMA(0, 1, At, B1); PG8_BAR;
            PG8_LDA(At, 1, 1); PG8_STAGE(PG8_SA(1, 0), a3, voffA);
            PG8_BAR; PG8_WAIT_L(0); PG8_MMA(1, 0, At, B0); PG8_BAR; PG8_SCHED;
            PG8_STAGE(PG8_SB(1, 1), b3 + hstep, voffB);
            PG8_WAIT_V(6); PG8_BAR; PG8_MMA(1, 1, At, B1); PG8_BAR;
            }
        }
        if constexpr (ALIGN_EPI) { if (wr == 0) PG8_BAR; }
        if constexpr (!Epi::AFTER_DRAIN) { E(acc, cur, wr, wc, fr, fq); S.done(cur); }
        if (!has_next) break;
#pragma unroll
        for (int a = 0; a < 2; ++a)
#pragma unroll
            for (int b = 0; b < 2; ++b)
#pragma unroll
                for (int m = 0; m < 4; ++m)
#pragma unroll
                    for (int n = 0; n < 2; ++n) acc[a][b][m][n] = (f32x4){0.f, 0.f, 0.f, 0.f};
        cur = nxt; cA = nA; cB = nB; ++ui;
        if constexpr (ALIGN_EPI) { if (wr == 1) PG8_BAR; }
    }
    PG8_WAIT_V(0);
    if constexpr (!ALIGN_EPI) { if (wr == 0) PG8_BAR; }
    PG8_BAR;
    if constexpr (Epi::AFTER_DRAIN) { E.fused(acc, cur, wr, wc, fr, fq, lds, wid, lane); S.done(cur); }
#undef PG8_SA
#undef PG8_SB
#undef PG8_STAGE
#undef PG8_LDA
#undef PG8_LDB
#undef PG8_MMA
#undef PG8_WAIT_V
#undef PG8_WAIT_L
#undef PG8_BAR
#undef PG8_SCHED
}


typedef float f32x2_t __attribute__((ext_vector_type(2))); typedef __bf16 bf16x2_t __attribute__((ext_vector_type(2)));
__device__ __forceinline__ unsigned cvt_pk_bf16(float lo, float hi) { f32x2_t v = {lo, hi}; bf16x2_t b = __builtin_convertvector(v, bf16x2_t); return __builtin_bit_cast(unsigned, b); }
struct HookNone { __device__ __forceinline__ void at(int, f32x4 (&)[2][2][4][2], const Unit&, int, int, int, int) const {} };
__device__ __forceinline__ float fast_sigm(float v) { return __builtin_amdgcn_rcpf(1.f + __builtin_amdgcn_exp2f(-1.4426950408889634f * v)); }
__device__ __forceinline__ u32x4 pack8(const f32x4 a, const f32x4 b) { u32x4 w; w.x = cvt_pk_bf16(a[0], a[1]); w.y = cvt_pk_bf16(a[2], a[3]); w.z = cvt_pk_bf16(b[0], b[1]); w.w = cvt_pk_bf16(b[2], b[3]); return w; }
struct EpiPlain {
    static constexpr bool PERM = true, AFTER_DRAIN = false;
    bf16_t* O; int ldc;
    __device__ __forceinline__ void operator()(const f32x4 (&acc)[2][2][4][2], const Unit& u, int wr, int wc, int fr, int fq) const {
        const int row0 = u.pm * BM + wr * 64 + fr, col0 = u.pn * BM + wc * 32 + 8 * fq;
#pragma unroll
        for (int ai = 0; ai < 2; ++ai)
#pragma unroll
            for (int m = 0; m < 4; ++m) { bf16_t* rowp = O + (size_t)(row0 + ai * HALF + m * 16) * ldc + col0;
#pragma unroll
                for (int bj = 0; bj < 2; ++bj) *(u32x4*)(rowp + bj * HALF) = pack8(acc[ai][bj][m][0], acc[ai][bj][m][1]); }
    }
};
struct EpiInP {
    static constexpr bool PERM = true, AFTER_DRAIN = false;
    bf16_t *QKVA, *U, *QKVB, *QC, *MG; const float *rope, *merge_bias; int nofs;
    __device__ __forceinline__ void operator()(const f32x4 (&acc)[2][2][4][2], const Unit& u, int wr, int wc, int fr, int fq) const {
        const int np0 = nofs + u.pn * BM;
        const int row0 = u.pm * BM + wr * 64 + fr, cofs = wc * 32 + 8 * fq;
        bf16_t* base; int ldc, cb, kind; float sc = 1.f;
        if (np0 < 4608)      { base = QKVA; ldc = 4608; cb = np0; const int part = np0 >> 9; kind = (part % 3 == 2) ? 0 : 1; if (part % 3 == 0) sc = 0.125f * 1.4426950408889634f; }
        else if (np0 < 5120) { base = U; ldc = 1536; cb = np0 - 4608; kind = 2; }
        else if (np0 < 6656) { base = QKVB; ldc = 1536; cb = np0 - 5120; kind = 0; if (cb < 512) sc = 0.125f * 1.4426950408889634f; }
        else if (np0 < 7168) { base = QC; ldc = 512; cb = np0 - 6656; kind = 0; sc = 0.08838834764831845f * 1.4426950408889634f; }
        else if (np0 < 8192) { base = U; ldc = 1536; cb = 512 + (np0 - 7168); kind = 2; }
        else                 { base = MG; ldc = 3072; cb = np0 - 8192; kind = 3; }
        bf16_t* outp = base + (size_t)row0 * ldc + cb + cofs;
        if (kind == 0) {
#pragma unroll
            for (int ai = 0; ai < 2; ++ai)
#pragma unroll
                for (int m = 0; m < 4; ++m)
#pragma unroll
                    for (int bj = 0; bj < 2; ++bj) *(u32x4*)(outp + (size_t)(ai * HALF + m * 16) * ldc + bj * HALF) = pack8(acc[ai][bj][m][0] * sc, acc[ai][bj][m][1] * sc);
        } else if (kind == 1) {
            const bool wrope = (wc & 1) == 0; const bool lrope = wrope && fq < 2; const float sgn = (fq == 0) ? -1.f : 1.f;
#pragma unroll
            for (int ai = 0; ai < 2; ++ai)
#pragma unroll
                for (int m = 0; m < 4; ++m) {
                    const int row = row0 + ai * HALF + m * 16;
                    f32x4 cs0 = {1.f, 0.f, 1.f, 0.f}, cs1 = cs0, cs2 = cs0, cs3 = cs0;
                    if (lrope) { const f32x4* tp = (const f32x4*)(rope + (size_t)(row & 2047) * 16); cs0 = tp[0]; cs1 = tp[1]; cs2 = tp[2]; cs3 = tp[3]; }
#pragma unroll
                    for (int bj = 0; bj < 2; ++bj) {
                        f32x4 a = acc[ai][bj][m][0], b = acc[ai][bj][m][1];
                        if (wrope) {
                            f32x4 pa, pb;
#pragma unroll
                            for (int e = 0; e < 4; ++e) { pa[e] = __shfl_xor(a[e], 16); pb[e] = __shfl_xor(b[e], 16); }
                            a[0] = a[0] * cs0[0] + sgn * pa[0] * cs0[1]; a[1] = a[1] * cs0[2] + sgn * pa[1] * cs0[3];
                            a[2] = a[2] * cs1[0] + sgn * pa[2] * cs1[1]; a[3] = a[3] * cs1[2] + sgn * pa[3] * cs1[3];
                            b[0] = b[0] * cs2[0] + sgn * pb[0] * cs2[1]; b[1] = b[1] * cs2[2] + sgn * pb[1] * cs2[3];
                            b[2] = b[2] * cs3[0] + sgn * pb[2] * cs3[1]; b[3] = b[3] * cs3[2] + sgn * pb[3] * cs3[3];
                        }
                        *(u32x4*)(outp + (size_t)(ai * HALF + m * 16) * ldc + bj * HALF) = pack8(a * sc, b * sc);
                    }
                }
        } else if (kind == 2) {
#pragma unroll
            for (int ai = 0; ai < 2; ++ai)
#pragma unroll
                for (int m = 0; m < 4; ++m)
#pragma unroll
                    for (int bj = 0; bj < 2; ++bj) { f32x4 a = acc[ai][bj][m][0], b = acc[ai][bj][m][1];
#pragma unroll
                        for (int e = 0; e < 4; ++e) { a[e] *= fast_sigm(a[e]); b[e] *= fast_sigm(b[e]); }
                        *(u32x4*)(outp + (size_t)(ai * HALF + m * 16) * ldc + bj * HALF) = pack8(a, b); }
        } else {
            f32x4 bv[2][2];
#pragma unroll
            for (int bj = 0; bj < 2; ++bj) { bv[bj][0] = *(const f32x4*)(merge_bias + cb + cofs + bj * HALF); bv[bj][1] = *(const f32x4*)(merge_bias + cb + cofs + bj * HALF + 4); }
#pragma unroll
            for (int ai = 0; ai < 2; ++ai)
#pragma unroll
                for (int m = 0; m < 4; ++m)
#pragma unroll
                    for (int bj = 0; bj < 2; ++bj) { f32x4 a = acc[ai][bj][m][0] + bv[bj][0], b = acc[ai][bj][m][1] + bv[bj][1];
#pragma unroll
                        for (int e = 0; e < 4; ++e) { a[e] = fast_sigm(a[e]); b[e] = fast_sigm(b[e]); }
                        *(u32x4*)(outp + (size_t)(ai * HALF + m * 16) * ldc + bj * HALF) = pack8(a, b); }
        }
    }
};
__device__ __forceinline__ void unpack8(const u32x4 w, f32x4& a, f32x4& b) {
    a[0] = __builtin_bit_cast(float, w.x << 16); a[1] = __builtin_bit_cast(float, w.x & 0xffff0000u); a[2] = __builtin_bit_cast(float, w.y << 16); a[3] = __builtin_bit_cast(float, w.y & 0xffff0000u);
    b[0] = __builtin_bit_cast(float, w.z << 16); b[1] = __builtin_bit_cast(float, w.z & 0xffff0000u); b[2] = __builtin_bit_cast(float, w.w << 16); b[3] = __builtin_bit_cast(float, w.w & 0xffff0000u);
}
struct HookGate {
    const bf16_t* MG;
    __device__ __forceinline__ void at(int t, f32x4 (&acc)[2][2][4][2], const Unit& u, int wr, int wc, int fr, int fq) const {
        if (t != 8 && t != 16) return;
        const bf16_t* gp = MG + (size_t)(u.pm * BM + wr * 64 + fr) * 3072 + (t == 8 ? 0 : 1024) + u.pn * BM + wc * 32 + 8 * fq;
#pragma unroll
        for (int ai = 0; ai < 2; ++ai)
#pragma unroll
            for (int m = 0; m < 4; ++m)
#pragma unroll
                for (int bj = 0; bj < 2; ++bj) {
                    const bf16_t* p = gp + (size_t)(ai * HALF + m * 16) * 3072 + bj * HALF;
                    f32x4 na, nb, da, db; unpack8(*(const u32x4*)p, na, nb); unpack8(*(const u32x4*)(p + 1024), da, db);
#pragma unroll
                    for (int e = 0; e < 4; ++e) { acc[ai][bj][m][0][e] *= fmaxf(na[e], 1e-20f) * __builtin_amdgcn_rcpf(fmaxf(da[e], 1e-20f)); acc[ai][bj][m][1][e] *= fmaxf(nb[e], 1e-20f) * __builtin_amdgcn_rcpf(fmaxf(db[e], 1e-20f)); }
                }
    }
};
struct EpiY {
    static constexpr bool PERM = true, AFTER_DRAIN = false;
    const bf16_t* MG; bf16_t* Y;
    __device__ __forceinline__ void operator()(const f32x4 (&acc)[2][2][4][2], const Unit& u, int wr, int wc, int fr, int fq) const {
        const int row0 = u.pm * BM + wr * 64 + fr, col0 = u.pn * BM + wc * 32 + 8 * fq;
#pragma unroll
        for (int ai = 0; ai < 2; ++ai)
#pragma unroll
            for (int m = 0; m < 4; ++m)
#pragma unroll
                for (int bj = 0; bj < 2; ++bj) {
                    const size_t row = (size_t)(row0 + ai * HALF + m * 16);
                    f32x4 ga, gb; unpack8(*(const u32x4*)(MG + row * 3072 + 2048 + col0 + bj * HALF), ga, gb);
#pragma unroll
                    for (int e = 0; e < 4; ++e) { ga[e] = fmaxf(ga[e], 1e-20f) * acc[ai][bj][m][0][e]; gb[e] = fmaxf(gb[e], 1e-20f) * acc[ai][bj][m][1][e]; }
                    *(u32x4*)(Y + row * 1024 + col0 + bj * HALF) = pack8(ga, gb);
                }
    }
};
}

struct Frame {
    LAS unsigned char* lds;
    int tid, lane, wave, vcu, G, gw, NGW;
    const float *x, *mem, *pre_norm, *w_in, *merge_bias, *na_rpb, *mem_norm, *w_mem_kv, *w_br0, *w_br1, *w_br2, *w_out, *post_norm;
    float* out;
    float* rope;
    bf16_t *Wt_in, *Wt_kv, *Wt_br, *Wt_out, *XN, *Y, *MEMN, *KVM, *QKVA, *QKVB, *QC, *MG, *U;
};

__device__ __forceinline__ float wave_sum(float v) {
#pragma unroll
    for (int o = 1; o < 64; o <<= 1) v += __shfl_xor(v, o);
    return v;
}

__device__ __forceinline__ void p0_transpose_item(const float* W, int ldw, int c0, int k0, const float* g, bf16_t* WT, int ldt, int n0, int kofs, LAS float* scr, int lane) {
#pragma unroll 8
    for (int i = 0; i < 32; ++i) { const int kk = 2 * i + (lane >> 5); float v = W[(size_t)(k0 + kk) * ldw + c0 + (lane & 31)]; if (g) v *= g[k0 + kk]; scr[kk * 33 + (lane & 31)] = v; }
    LDS_WAIT(); asm volatile("" ::: "memory");
    const int c = lane & 7;
#pragma unroll
    for (int j = 0; j < 4; ++j) { const int n = (lane >> 3) + 8 * j; const LAS float* s = scr + (8 * c) * 33 + n;
        v4u o; o.x = pk2(s[0 * 33], s[1 * 33]); o.y = pk2(s[2 * 33], s[3 * 33]); o.z = pk2(s[4 * 33], s[5 * 33]); o.w = pk2(s[6 * 33], s[7 * 33]);
        *(GAS v4u*)(WT + (size_t)(n0 + n) * ldt + kofs + k0 + 8 * c) = o; }
    LDS_WAIT(); asm volatile("" ::: "memory");
}
__device__ __forceinline__ int win_col(int np) {
    if (np < 4608) return np;
    if (np < 5120) return 6656 + (np - 4608);
    if (np < 6656) return 4608 + (np - 5120);
    if (np < 7168) return 6144 + (np - 6656);
    return np;
}
__device__ __forceinline__ void rms_row_to_bf16(const float* xrow, bf16_t* orow, int lane) {
    const GAS f32x4* xr = (const GAS f32x4*)xrow + lane;
    f32x4 v[4]; float s = 0.f;
#pragma unroll
    for (int j = 0; j < 4; ++j) { v[j] = xr[64 * j]; s += (v[j].x * v[j].x + v[j].y * v[j].y) + (v[j].z * v[j].z + v[j].w * v[j].w); }
    const float rstd = 1.f / sqrtf(wave_sum(s) * (1.f / DM) + EPS);
    GAS unsigned long long* o8 = (GAS unsigned long long*)orow + lane;
#pragma unroll
    for (int j = 0; j < 4; ++j) o8[64 * j] = (unsigned long long)pk2(v[j].x * rstd, v[j].y * rstd) | ((unsigned long long)pk2(v[j].z * rstd, v[j].w * rstd) << 32);
}
__device__ __forceinline__ void p0_prologue(Frame& F) {
    LAS float* scr = (LAS float*)(F.lds + F.wave * 16384);
    constexpr int I_IN = 16 * (NIN / 32), I_KV = 16 * 32, I_BR = 8 * 32, I_OUT = 16 * 32;
    constexpr int NITEMS = I_IN + I_KV + 3 * I_BR + I_OUT;
    for (int it = F.gw; it < NITEMS; it += F.NGW) {
        int r = it;
        if (r < I_IN) { const int kb = r / (NIN / 32), nb = r % (NIN / 32); p0_transpose_item(F.w_in, NIN, win_col(32 * nb), 64 * kb, F.pre_norm, F.Wt_in, DM, 32 * nb, 0, scr, F.lane); continue; } r -= I_IN;
        if (r < I_KV) { const int kb = r / 32, nb = r % 32; p0_transpose_item(F.w_mem_kv, 1024, 32 * nb, 64 * kb, F.mem_norm, F.Wt_kv, DM, 32 * nb, 0, scr, F.lane); continue; } r -= I_KV;
        if (r < I_BR) { const int kb = r / 32, nb = r % 32; p0_transpose_item(F.w_br0, 1024, 32 * nb, 64 * kb, nullptr, F.Wt_br, 1536, 32 * nb, 0, scr, F.lane); continue; } r -= I_BR;
        if (r < I_BR) { const int kb = r / 32, nb = r % 32; p0_transpose_item(F.w_br1, 1024, 32 * nb, 64 * kb, nullptr, F.Wt_br, 1536, 32 * nb, 512, scr, F.lane); continue; } r -= I_BR;
        if (r < I_BR) { const int kb = r / 32, nb = r % 32; p0_transpose_item(F.w_br2, 1024, 32 * nb, 64 * kb, nullptr, F.Wt_br, 1536, 32 * nb, 1024, scr, F.lane); continue; } r -= I_BR;
        { const int kb = r / 32, nb = r % 32; p0_transpose_item(F.w_out, 1024, 32 * nb, 64 * kb, nullptr, F.Wt_out, DM, 32 * nb, 0, scr, F.lane); }
    }
    for (int m = F.gw; m < MTOK + MMEM; m += F.NGW) {
        if (m < MTOK) rms_row_to_bf16(F.x + (size_t)m * DM, F.XN + (size_t)m * DM, F.lane);
        else rms_row_to_bf16(F.mem + (size_t)(m - MTOK) * DM, F.MEMN + (size_t)(m - MTOK) * DM, F.lane);
    }
    for (int e = F.gw * 64 + F.lane; e < SEQ * 8; e += F.NGW * 64) {
        const int pos = e >> 3, i = e & 7;
        const double inv = exp(-(double)i * 0.125 * 13.122363377404328);
        const double ang = (double)pos * inv;
        F.rope[2 * e] = (float)cos(ang); F.rope[2 * e + 1] = (float)sin(ang);
    }
}

template <class Epi>
__device__ __forceinline__ void simple_gemm(const bf16_t* A, int lda, const bf16_t* Bt, int ldb, int Mr, int Nc, int K, const Frame& F, const Epi& E) {
    const int ntn = Nc / 32, nt = (Mr / 32) * ntn;
    const int r = F.lane & 31, h = F.lane >> 5;
    for (int t = F.gw; t < nt; t += F.NGW) {
        const int tm = t / ntn, tn = t % ntn;
        const bf16_t* ap = A + (size_t)(tm * 32 + r) * lda + 8 * h;
        const bf16_t* bp = Bt + (size_t)(tn * 32 + r) * ldb + 8 * h;
        f32x16 acc = {};
#pragma unroll 4
        for (int k = 0; k < K; k += 16) {
            const bf16x8 a = *(const bf16x8*)(ap + k), b = *(const bf16x8*)(bp + k);
            acc = __builtin_amdgcn_mfma_f32_32x32x16_bf16(a, b, acc, 0, 0, 0);
        }
#pragma unroll
        for (int i = 0; i < 16; ++i) E(tm * 32 + (i & 3) + 8 * (i >> 2) + 4 * h, tn * 32 + r, acc[i]);
    }
}
__device__ __forceinline__ float silu_f(float v) { return v / (1.f + __expf(-v)); }
__device__ __forceinline__ float sigm_f(float v) { return 1.f / (1.f + __expf(-v)); }

struct EpiIn {
    bf16_t *QKVA, *U, *QKVB, *QC, *MG; const float *rope, *merge_bias; int nofs;
    __device__ __forceinline__ void operator()(int row, int colr, float v) const {
        const int np = colr + nofs;
        const float partner = __shfl_xor(v, 8);
        if (np < 4608) {
            const int part = np >> 9, d = np & 63, kind = part % 3;
            if (kind != 2 && d < 16) {
                const int pos = row & (SEQ - 1); const float* cs = rope + ((pos << 3) + (d & 7)) * 2; const float c = cs[0], s = cs[1];
                v = (d < 8) ? (v * c - partner * s) : (v * c + partner * s);
            }
            if (kind == 0) v *= QS64;
            QKVA[(size_t)row * WA + np] = (bf16_t)f2bf(v);
        } else if (np < 5120) {
            U[(size_t)row * WU + (np - 4608)] = (bf16_t)f2bf(silu_f(v));
        } else if (np < 6656) {
            const int j = np - 5120; if (j < 512) v *= QS64;
            QKVB[(size_t)row * WB + j] = (bf16_t)f2bf(v);
        } else if (np < 7168) {
            QC[(size_t)row * WC + (np - 6656)] = (bf16_t)f2bf(v * QS128);
        } else if (np < 8192) {
            U[(size_t)row * WU + 512 + (np - 7168)] = (bf16_t)f2bf(silu_f(v));
        } else {
            const int j = np - 8192;
            MG[(size_t)row * WG + j] = (bf16_t)f2bf(sigm_f(v + merge_bias[j]));
        }
    }
};
struct EpiKv { bf16_t* KVM; __device__ __forceinline__ void operator()(int row, int col, float v) const { KVM[(size_t)row * DM + col] = (bf16_t)f2bf(v); } };
struct EpiF32 { float* O; __device__ __forceinline__ void operator()(int row, int col, float v) const { O[(size_t)row * DM + col] = v; } };

__device__ __forceinline__ void p3_simple(const Frame& F) {
    const int ntn = DM / 32, nt = (MTOK / 32) * ntn;
    const int r = F.lane & 31, h = F.lane >> 5;
    for (int t = F.gw; t < nt; t += F.NGW) {
        const int tm = t / ntn, tn = t % ntn;
        f32x16 y = {};
#pragma unroll 1
        for (int br = 0; br < 3; ++br) {
            const bf16_t* ap = F.U + (size_t)(tm * 32 + r) * WU + br * 512 + 8 * h;
            const bf16_t* bp = F.Wt_br + (size_t)(tn * 32 + r) * 1536 + br * 512 + 8 * h;
            f32x16 acc = {};
#pragma unroll 4
            for (int k = 0; k < 512; k += 16) {
                const bf16x8 a = *(const bf16x8*)(ap + k), b = *(const bf16x8*)(bp + k);
                acc = __builtin_amdgcn_mfma_f32_32x32x16_bf16(a, b, acc, 0, 0, 0);
            }
#pragma unroll
            for (int i = 0; i < 16; ++i) { const int row = tm * 32 + (i & 3) + 8 * (i >> 2) + 4 * h; y[i] += bf2f(F.MG[(size_t)row * WG + br * 1024 + tn * 32 + r]) * acc[i]; }
        }
#pragma unroll
        for (int i = 0; i < 16; ++i) { const int row = tm * 32 + (i & 3) + 8 * (i >> 2) + 4 * h; F.Y[(size_t)row * DM + tn * 32 + r] = (bf16_t)f2bf(y[i]); }
    }
}

__device__ __forceinline__ void ld64(const bf16_t* p, float (&q)[64]) {
#pragma unroll
    for (int c = 0; c < 8; ++c) { const v4u w = *(const v4u*)(p + 8 * c);
        q[8 * c + 0] = blo(w.x); q[8 * c + 1] = bhi(w.x); q[8 * c + 2] = blo(w.y); q[8 * c + 3] = bhi(w.y);
        q[8 * c + 4] = blo(w.z); q[8 * c + 5] = bhi(w.z); q[8 * c + 6] = blo(w.w); q[8 * c + 7] = bhi(w.w); }
}
__device__ __forceinline__ float dot64(const bf16_t* p, const float (&q)[64]) {
    float s0 = 0.f, s1 = 0.f;
#pragma unroll
    for (int c = 0; c < 8; ++c) { const v4u w = *(const v4u*)(p + 8 * c);
        s0 += q[8 * c + 0] * blo(w.x); s1 += q[8 * c + 1] * bhi(w.x); s0 += q[8 * c + 2] * blo(w.y); s1 += q[8 * c + 3] * bhi(w.y);
        s0 += q[8 * c + 4] * blo(w.z); s1 += q[8 * c + 5] * bhi(w.z); s0 += q[8 * c + 6] * blo(w.w); s1 += q[8 * c + 7] * bhi(w.w); }
    return s0 + s1;
}
__device__ __forceinline__ void axpy64(const bf16_t* p, float a, float (&o)[64]) {
#pragma unroll
    for (int c = 0; c < 8; ++c) { const v4u w = *(const v4u*)(p + 8 * c);
        o[8 * c + 0] += a * blo(w.x); o[8 * c + 1] += a * bhi(w.x); o[8 * c + 2] += a * blo(w.y); o[8 * c + 3] += a * bhi(w.y);
        o[8 * c + 4] += a * blo(w.z); o[8 * c + 5] += a * bhi(w.z); o[8 * c + 6] += a * blo(w.w); o[8 * c + 7] += a * bhi(w.w); }
}
#define ONLINE_STEP(sc, vptr) do { if ((sc) > mx) { const float f_ = exp2f(mx - (sc)); l *= f_; _Pragma("unroll") for (int d_ = 0; d_ < 64; ++d_) o[d_] *= f_; mx = (sc); } \
    const float p_ = exp2f((sc) - mx); l += p_; axpy64((vptr), p_, o); } while (0)
__device__ __forceinline__ void gate_store64(bf16_t* up, const float (&o)[64], float inv) {
#pragma unroll
    for (int c = 0; c < 8; ++c) { const v4u w = *(const v4u*)(up + 8 * c); v4u r;
        r.x = pk2(o[8 * c + 0] * inv * blo(w.x), o[8 * c + 1] * inv * bhi(w.x)); r.y = pk2(o[8 * c + 2] * inv * blo(w.y), o[8 * c + 3] * inv * bhi(w.y));
        r.z = pk2(o[8 * c + 4] * inv * blo(w.z), o[8 * c + 5] * inv * bhi(w.z)); r.w = pk2(o[8 * c + 6] * inv * blo(w.w), o[8 * c + 7] * inv * bhi(w.w));
        *(v4u*)(up + 8 * c) = r; }
}
__device__ __forceinline__ void attn_a_naive(const Frame& F) {
    for (int idx = F.vcu * 512 + F.tid; idx < MTOK * 8; idx += F.G * 512) {
        const int tok = idx >> 3, h = idx & 7, b = tok >> 11, s = tok & (SEQ - 1);
        float o[64]; float mx = -1e30f, l = 0.f;
#pragma unroll
        for (int d = 0; d < 64; ++d) o[d] = 0.f;
#pragma unroll 1
        for (int g = 0; g < 3; ++g) {
            const int dil = (g == 0) ? 1 : (g == 1 ? 4 : 16), mlen = SEQ / dil, m = s / dil, r = s % dil;
            float q[64]; ld64(F.QKVA + (size_t)tok * WA + (3 * g) * 512 + h * 64, q);
            const int j0 = (m - 64 > 0) ? m - 64 : 0, j1 = (m + 64 < mlen - 1) ? m + 64 : mlen - 1;
            for (int j = j0; j <= j1; ++j) {
                const size_t kt = (size_t)(b * SEQ + j * dil + r) * WA + h * 64;
                const float sc = dot64(F.QKVA + kt + (3 * g + 1) * 512, q);
                ONLINE_STEP(sc, F.QKVA + kt + (3 * g + 2) * 512);
            }
        }
        gate_store64(F.U + (size_t)tok * WU + h * 64, o, 1.f / l);
    }
}
__device__ __forceinline__ void attn_b_naive(const Frame& F) {
    for (int idx = F.vcu * 512 + F.tid; idx < MTOK * 8; idx += F.G * 512) {
        const int tok = idx >> 3, h = idx & 7, b = tok >> 11, s = tok & (SEQ - 1), r = s >> 6, c = s & 63;
        const int rs = (r - 4 < 0) ? 0 : (r - 4 > 24 ? 24 : r - 4), cs = (c - 8 < 0) ? 0 : (c - 8 > 48 ? 48 : c - 8);
        float o[64]; float mx = -1e30f, l = 0.f;
#pragma unroll
        for (int d = 0; d < 64; ++d) o[d] = 0.f;
        float q[64]; ld64(F.QKVB + (size_t)tok * WB + h * 64, q);
        for (int kr = 0; kr < 8; ++kr)
            for (int kc = 0; kc < 16; ++kc) {
                const size_t kt = (size_t)(b * SEQ + (rs + kr) * 64 + cs + kc) * WB + h * 64;
                const float bias = F.na_rpb[(h * 15 + (rs + kr - r + 7)) * 31 + (cs + kc - c + 15)] * LOG2E;
                const float sc = dot64(F.QKVB + kt + 512, q) + bias;
                ONLINE_STEP(sc, F.QKVB + kt + 1024);
            }
        gate_store64(F.U + (size_t)tok * WU + 512 + h * 64, o, 1.f / l);
    }
}
__device__ __forceinline__ void attn_c_naive(const Frame& F) {
    for (int idx = F.vcu * 512 + F.tid; idx < MTOK * 8; idx += F.G * 512) {
        const int tok = idx >> 3, h = (idx >> 1) & 3, half = idx & 1, b = tok >> 11;
        float o[64]; float mx = -1e30f, l = 0.f;
#pragma unroll
        for (int d = 0; d < 64; ++d) o[d] = 0.f;
        float q[64]; ld64(F.QC + (size_t)tok * WC + h * 128 + half * 64, q);
        for (int j = 0; j < MEMLEN; ++j) {
            const size_t kt = (size_t)(b * MEMLEN + j) * DM + h * 128 + half * 64;
            float sc = dot64(F.KVM + kt, q); sc += __shfl_xor(sc, 1);
            ONLINE_STEP(sc, F.KVM + kt + 512);
        }
        gate_store64(F.U + (size_t)tok * WU + 1024 + h * 128 + half * 64, o, 1.f / l);
    }
}

namespace att {
typedef short s16x4 __attribute__((ext_vector_type(4)));
typedef short v4i16_t __attribute__((ext_vector_type(4)));
__device__ __forceinline__ s16x4 vtr(LAS unsigned char* p) { return __builtin_bit_cast(s16x4, __builtin_amdgcn_ds_read_tr16_b64_v4i16((LAS v4i16_t*)p)); }
__device__ __forceinline__ unsigned cvtpk(float lo, float hi) { return pg8::cvt_pk_bf16(lo, hi); }
__device__ __forceinline__ float xhalf_max(float v) { auto rr = __builtin_amdgcn_permlane32_swap(__float_as_uint(v), __float_as_uint(v), false, false); return fmaxf(__uint_as_float(rr[0]), __uint_as_float(rr[1])); }
__device__ __forceinline__ float xhalf_sum(float v) { auto rr = __builtin_amdgcn_permlane32_swap(__float_as_uint(v), __float_as_uint(v), false, false); return __uint_as_float(rr[0]) + __uint_as_float(rr[1]); }
#define ATT_CR(r) (((r) & 3) + 8 * ((r) >> 2))
constexpr float NEGINF = -__builtin_huge_valf();

template <int D> struct Tile {
    static constexpr int ND = D / 16, NB = D / 32, NVI = D / 16;
    bf16x8 qr[ND]; f32x16 o[NB]; float m, l;
    __device__ __forceinline__ void init(const bf16_t* qp) {
#pragma unroll
        for (int d0 = 0; d0 < ND; ++d0) qr[d0] = *(const bf16x8*)(qp + 16 * d0);
#pragma unroll
        for (int b = 0; b < NB; ++b) o[b] = f32x16{};
        m = -1e30f; l = 0.f;
    }
};
template <int D> struct KV { bf16x8 kf[D / 16]; v4u vr[D / 16]; };
template <int D> __device__ __forceinline__ void kv_load(KV<D>& t, const bf16_t* kp, const bf16_t* vp, size_t vstep) {
#pragma unroll
    for (int d0 = 0; d0 < D / 16; ++d0) t.kf[d0] = *(const bf16x8*)(kp + 16 * d0);
#pragma unroll
    for (int i = 0; i < D / 16; ++i) t.vr[i] = *(const v4u*)(vp + (size_t)i * vstep);
}
template <int D> __device__ __forceinline__ int v_key(int i, int lane) { return D == 64 ? 8 * i + (lane >> 3) : 4 * i + (lane >> 4); }
template <int D> __device__ __forceinline__ int v_chunk(int lane) { return D == 64 ? (lane & 7) : (lane & 15); }
template <int D> __device__ __forceinline__ f32x16 scores(const Tile<D>& T, const KV<D>& t) {
    f32x16 p = f32x16{};
#pragma unroll
    for (int d0 = 0; d0 < D / 16; ++d0) p = __builtin_amdgcn_mfma_f32_32x32x16_bf16(t.kf[d0], T.qr[d0], p, 0, 0, 0);
    return p;
}
template <int D> __device__ __forceinline__ void softmax_pv(Tile<D>& T, const KV<D>& t, f32x16 p, LAS unsigned char* vl, int lane) {
    const int hi = lane >> 5;
#pragma unroll
    for (int i = 0; i < D / 16; ++i) { const int key = v_key<D>(i, lane), c = v_chunk<D>(lane);
        *(LAS v4u*)(vl + (c >> 2) * 2048 + (key >> 4) * 1024 + (key & 15) * 64 + (c & 3) * 16) = t.vr[i]; }
    float tm = fmaxf(fmaxf(p[0], p[1]), fmaxf(p[2], p[3]));
#pragma unroll
    for (int r = 4; r < 16; r += 4) tm = fmaxf(tm, fmaxf(fmaxf(p[r], p[r + 1]), fmaxf(p[r + 2], p[r + 3])));
    tm = xhalf_max(tm);
    const float mn = fmaxf(T.m, tm), sc = __builtin_amdgcn_exp2f(T.m - mn); T.m = mn;
    float ps = 0.f;
#pragma unroll
    for (int r = 0; r < 16; ++r) { p[r] = __builtin_amdgcn_exp2f(p[r] - mn); ps += p[r]; }
    T.l = T.l * sc + ps;
#pragma unroll
    for (int b = 0; b < D / 32; ++b) T.o[b] = T.o[b] * sc;
    v4u pw0, pw1;
    pw0.x = cvtpk(p[0], p[1]); pw0.y = cvtpk(p[2], p[3]); pw0.z = cvtpk(p[4], p[5]); pw0.w = cvtpk(p[6], p[7]);
    pw1.x = cvtpk(p[8], p[9]); pw1.y = cvtpk(p[10], p[11]); pw1.z = cvtpk(p[12], p[13]); pw1.w = cvtpk(p[14], p[15]);
    const bf16x8 pa0 = __builtin_bit_cast(bf16x8, pw0), pa1 = __builtin_bit_cast(bf16x8, pw1);
    LAS unsigned char* vp0 = vl + ((lane >> 4) & 1) * 32 + (lane & 3) * 8 + (4 * hi + ((lane & 15) >> 2)) * 64;
#pragma unroll
    for (int b = 0; b < D / 32; ++b) {
        const s16x4 l0 = vtr(vp0 + b * 2048), h0 = vtr(vp0 + b * 2048 + 512), l1 = vtr(vp0 + b * 2048 + 1024), h1 = vtr(vp0 + b * 2048 + 1536);
        const bf16x8 v0 = (bf16x8){l0[0], l0[1], l0[2], l0[3], h0[0], h0[1], h0[2], h0[3]}, v1 = (bf16x8){l1[0], l1[1], l1[2], l1[3], h1[0], h1[1], h1[2], h1[3]};
        T.o[b] = __builtin_amdgcn_mfma_f32_32x32x16_bf16(v0, pa0, T.o[b], 0, 0, 0);
        T.o[b] = __builtin_amdgcn_mfma_f32_32x32x16_bf16(v1, pa1, T.o[b], 0, 0, 0);
    }
}
}
__device__ __forceinline__ void attn_a_unit(const Frame& F, int b, int h, int s4, float* LSE) {
    using namespace att;
    const int lane = F.lane, r32 = lane & 31, hi = lane >> 5;
    LAS unsigned char* vl = F.lds + F.wave * 8192;
    bf16_t* const base = F.QKVA + (size_t)b * SEQ * WA + h * 64;
#pragma unroll 1
    for (int g = 0; g < 3; ++g) {
        const int dil = (g == 0) ? 1 : (g == 1 ? 4 : 16), mlen = SEQ / dil;
        const size_t tstride = (size_t)dil * WA;
#pragma unroll 1
        for (int tt = 0; tt < 2; ++tt) {
            const int ti = F.wave * 2 + tt;
            int res, q0p;
            if (g == 0) { res = 0; q0p = 512 * s4 + 32 * ti; } else if (g == 1) { res = ti >> 2; q0p = 128 * s4 + 32 * (ti & 3); } else { res = ti; q0p = 32 * s4; }
            bf16_t* const gb = base + (size_t)res * WA + (3 * g) * 512;
            Tile<64> T; T.init(gb + (size_t)(q0p + r32) * tstride + 8 * hi);
            int jlo = 0, jhi = 4;
            while (q0p - 64 + 32 * jlo < 0) ++jlo;
            while (q0p - 64 + 32 * jhi >= mlen) --jhi;
            KV<64> cur;
            { const int kp0 = q0p - 64 + 32 * jlo;
              kv_load<64>(cur, gb + 512 + (size_t)(kp0 + r32) * tstride + 8 * hi, gb + 1024 + (size_t)(kp0 + (lane >> 3)) * tstride + 8 * (lane & 7), 8 * tstride); }
#pragma unroll 1
            for (int j = jlo; j <= jhi; ++j) {
                KV<64> nxt = cur;
                if (j < jhi) { const int kp0 = q0p - 64 + 32 * (j + 1);
                    kv_load<64>(nxt, gb + 512 + (size_t)(kp0 + r32) * tstride + 8 * hi, gb + 1024 + (size_t)(kp0 + (lane >> 3)) * tstride + 8 * (lane & 7), 8 * tstride); }
                f32x16 p = scores<64>(T, cur);
                if (j == 0) {
#pragma unroll
                    for (int r = 0; r < 16; ++r) if (ATT_CR(r) + 4 * hi < r32) p[r] = NEGINF;
                } else if (j == 4) {
#pragma unroll
                    for (int r = 0; r < 16; ++r) if (ATT_CR(r) + 4 * hi > r32) p[r] = NEGINF;
                }
                softmax_pv<64>(T, cur, p, vl, lane);
                cur = nxt;
            }
            const float lt = xhalf_sum(T.l), inv = 1.f / lt;
            const size_t tokrow = (size_t)(q0p + r32) * tstride;
            bf16_t* op = gb + tokrow + 4 * hi;
#pragma unroll
            for (int bb = 0; bb < 2; ++bb)
#pragma unroll
                for (int gq = 0; gq < 4; ++gq) { uint2 w; w.x = cvtpk(T.o[bb][4 * gq] * inv, T.o[bb][4 * gq + 1] * inv); w.y = cvtpk(T.o[bb][4 * gq + 2] * inv, T.o[bb][4 * gq + 3] * inv);
                    *(uint2*)(op + 32 * bb + 8 * gq) = w; }
            if (hi == 0) LSE[((size_t)g * MTOK + (size_t)b * SEQ + (size_t)(q0p + r32) * dil + res) * 8 + h] = T.m + __builtin_amdgcn_logf(lt);
        }
    }
    asm volatile("s_waitcnt vmcnt(0)" ::: "memory");
    __syncthreads();
    {
        const size_t tok = (size_t)b * SEQ + 512 * s4 + F.tid;
        const float l0 = LSE[(0 * (size_t)MTOK + tok) * 8 + h], l1 = LSE[(1 * (size_t)MTOK + tok) * 8 + h], l2 = LSE[(2 * (size_t)MTOK + tok) * 8 + h];
        const float M = fmaxf(l0, fmaxf(l1, l2));
        float w0 = __builtin_amdgcn_exp2f(l0 - M), w1 = __builtin_amdgcn_exp2f(l1 - M), w2 = __builtin_amdgcn_exp2f(l2 - M);
        const float iw = 1.f / (w0 + w1 + w2); w0 *= iw; w1 *= iw; w2 *= iw;
        const bf16_t* o0 = F.QKVA + tok * WA + h * 64; bf16_t* up = F.U + tok * WU + h * 64;
#pragma unroll
        for (int c = 0; c < 8; ++c) {
            const v4u a = *(const v4u*)(o0 + 8 * c), bq = *(const v4u*)(o0 + 1536 + 8 * c), cq = *(const v4u*)(o0 + 3072 + 8 * c), gt = *(const v4u*)(up + 8 * c);
            v4u r;
            r.x = pk2((w0 * blo(a.x) + w1 * blo(bq.x) + w2 * blo(cq.x)) * blo(gt.x), (w0 * bhi(a.x) + w1 * bhi(bq.x) + w2 * bhi(cq.x)) * bhi(gt.x));
            r.y = pk2((w0 * blo(a.y) + w1 * blo(bq.y) + w2 * blo(cq.y)) * blo(gt.y), (w0 * bhi(a.y) + w1 * bhi(bq.y) + w2 * bhi(cq.y)) * bhi(gt.y));
            r.z = pk2((w0 * blo(a.z) + w1 * blo(bq.z) + w2 * blo(cq.z)) * blo(gt.z), (w0 * bhi(a.z) + w1 * bhi(bq.z) + w2 * bhi(cq.z)) * bhi(gt.z));
            r.w = pk2((w0 * blo(a.w) + w1 * blo(bq.w) + w2 * blo(cq.w)) * blo(gt.w), (w0 * bhi(a.w) + w1 * bhi(bq.w) + w2 * bhi(cq.w)) * bhi(gt.w));
            *(v4u*)(up + 8 * c) = r;
        }
    }
}
__device__ __forceinline__ void attn_a_phase(const Frame& F, float* LSE) {
    for (int it = F.vcu; it < BATCH * 8 * 4; it += F.G) { attn_a_unit(F, it >> 5, (it >> 2) & 7, it & 3, LSE); __syncthreads(); }
}
constexpr int RPB_OFF = 65536, RPB_HEAD = 17 * 64;
__device__ __forceinline__ void attn_b_table(const Frame& F) {
    LAS float* T = (LAS float*)(F.lds + RPB_OFF);
    for (int e = F.tid; e < 8 * RPB_HEAD; e += 512) { const int h = e / RPB_HEAD, q = e % RPB_HEAD, dr = (q >> 6) - 8, dc = (q & 63) - 31;
        T[e] = (dr >= -7 && dr <= 7 && dc >= -15 && dc <= 15) ? F.na_rpb[(h * 15 + dr + 7) * 31 + dc + 15] * LOG2E : 0.f; }
}
__device__ __forceinline__ void attn_b_item(const Frame& F, int b, int h, int rp, int cb) {
    using namespace att;
    const int lane = F.lane, r32 = lane & 31, hi = lane >> 5;
    LAS unsigned char* vl = F.lds + F.wave * 8192;
    const int qrow = 2 * rp + (r32 >> 4), qcol = 16 * cb + (r32 & 15);
    const size_t tq = (size_t)b * SEQ + qrow * 64 + qcol;
    bf16_t* const base = F.QKVB + (size_t)b * SEQ * WB + h * 64;
    Tile<64> T; T.init(F.QKVB + tq * WB + h * 64 + 8 * hi);
    const int s = (16 * cb - 8 < 0) ? 0 : (16 * cb - 8 > 32 ? 32 : 16 * cb - 8);
    const int kr_lo = (2 * rp - 4 < 0) ? 0 : (2 * rp - 4 > 24 ? 24 : 2 * rp - 4);
    const int rs1 = (2 * rp - 3 < 0) ? 0 : (2 * rp - 3 > 24 ? 24 : 2 * rp - 3), kr_hi = rs1 + 7;
    const int rs = (qrow - 4 < 0) ? 0 : (qrow - 4 > 24 ? 24 : qrow - 4), cs = (qcol - 8 < 0) ? 0 : (qcol - 8 > 48 ? 48 : qcol - 8);
    const int lo = cs - s - 4 * hi;
    LAS unsigned char* tb0 = F.lds + RPB_OFF + (h * RPB_HEAD + (s - qcol + 4 * hi + 31)) * 4;
    KV<64> cur;
    kv_load<64>(cur, base + 512 + (size_t)(kr_lo * 64 + s + r32) * WB + 8 * hi, base + 1024 + (size_t)(kr_lo * 64 + s + (lane >> 3)) * WB + 8 * (lane & 7), (size_t)8 * WB);
#pragma unroll 1
    for (int kr = kr_lo; kr <= kr_hi; ++kr) {
        KV<64> nxt = cur;
        if (kr < kr_hi) kv_load<64>(nxt, base + 512 + (size_t)((kr + 1) * 64 + s + r32) * WB + 8 * hi, base + 1024 + (size_t)((kr + 1) * 64 + s + (lane >> 3)) * WB + 8 * (lane & 7), (size_t)8 * WB);
        f32x16 p = scores<64>(T, cur);
        const bool rowok = (unsigned)(kr - rs) < 8u;
        LAS unsigned char* tb = tb0 + (kr - qrow + 8) * 256;
#pragma unroll
        for (int r = 0; r < 16; ++r) { const float bias = *(LAS float*)(tb + ATT_CR(r) * 4); const bool ok = rowok && (unsigned)(ATT_CR(r) - lo) < 16u; p[r] = ok ? p[r] + bias : NEGINF; }
        softmax_pv<64>(T, cur, p, vl, lane);
        cur = nxt;
    }
    const float inv = 1.f / xhalf_sum(T.l);
    bf16_t* up = F.U + tq * WU + 512 + h * 64 + 4 * hi;
#pragma unroll
    for (int bb = 0; bb < 2; ++bb)
#pragma unroll
        for (int gq = 0; gq < 4; ++gq) { const uint2 gt = *(const uint2*)(up + 32 * bb + 8 * gq); uint2 w;
            w.x = cvtpk(T.o[bb][4 * gq] * inv * blo(gt.x), T.o[bb][4 * gq + 1] * inv * bhi(gt.x)); w.y = cvtpk(T.o[bb][4 * gq + 2] * inv * blo(gt.y), T.o[bb][4 * gq + 3] * inv * bhi(gt.y));
            *(uint2*)(up + 32 * bb + 8 * gq) = w; }
}
__device__ __forceinline__ void attn_c_item(const Frame& F, int b, int h, int qt) {
    using namespace att;
    const int lane = F.lane, r32 = lane & 31, hi = lane >> 5;
    LAS unsigned char* vl = F.lds + F.wave * 8192;
    const size_t tq = (size_t)b * SEQ + qt * 32 + r32;
    Tile<128> T; T.init(F.QC + tq * WC + h * 128 + 8 * hi);
    const bf16_t* const kb = F.KVM + (size_t)b * MEMLEN * DM + h * 128;
#pragma unroll 1
    for (int j = 0; j < 8; ++j) {
        KV<128> cur;
        kv_load<128>(cur, kb + (size_t)(32 * j + r32) * DM + 8 * hi, kb + 512 + (size_t)(32 * j + (lane >> 4)) * DM + 8 * (lane & 15), (size_t)4 * DM);
        f32x16 p = scores<128>(T, cur);
        softmax_pv<128>(T, cur, p, vl, lane);
    }
    const float inv = 1.f / xhalf_sum(T.l);
    bf16_t* up = F.U + tq * WU + 1024 + h * 128 + 4 * hi;
#pragma unroll
    for (int bb = 0; bb < 4; ++bb)
#pragma unroll
        for (int gq = 0; gq < 4; ++gq) { const uint2 gt = *(const uint2*)(up + 32 * bb + 8 * gq); uint2 w;
            w.x = cvtpk(T.o[bb][4 * gq] * inv * blo(gt.x), T.o[bb][4 * gq + 1] * inv * bhi(gt.x)); w.y = cvtpk(T.o[bb][4 * gq + 2] * inv * blo(gt.y), T.o[bb][4 * gq + 3] * inv * bhi(gt.y));
            *(uint2*)(up + 32 * bb + 8 * gq) = w; }
}
__device__ __forceinline__ void attn_bc_phase(const Frame& F) {
    attn_b_table(F);
    __syncthreads();
    for (int it = F.gw; it < BATCH * 8 * 16 * 4; it += F.NGW) attn_b_item(F, it >> 9, (it >> 6) & 7, (it >> 2) & 15, it & 3);
    for (int it = F.gw; it < BATCH * 4 * 64; it += F.NGW) attn_c_item(F, it >> 8, (it >> 6) & 3, it & 63);
}

__device__ __forceinline__ void p5_rows(const Frame& F) {
    for (int m = F.gw; m < MTOK; m += F.NGW) {
        GAS f32x4* zr = (GAS f32x4*)(F.out + (size_t)m * DM) + F.lane; const GAS f32x4* xr = (const GAS f32x4*)(F.x + (size_t)m * DM) + F.lane; const GAS f32x4* pn = (const GAS f32x4*)F.post_norm + F.lane;
        f32x4 v[4]; float s = 0.f;
#pragma unroll
        for (int j = 0; j < 4; ++j) { v[j] = zr[64 * j]; s += (v[j].x * v[j].x + v[j].y * v[j].y) + (v[j].z * v[j].z + v[j].w * v[j].w); }
        const float rstd = 1.f / sqrtf(wave_sum(s) * (1.f / DM) + EPS);
#pragma unroll
        for (int j = 0; j < 4; ++j) zr[64 * j] = xr[64 * j] + v[j] * rstd * pn[64 * j];
    }
}

struct Args { const float* in[13]; float* out; unsigned char* ws; int ph_lo, ph_hi, li, pad; };
__global__ void __launch_bounds__(512, 2) fwd_kernel(Args args) {
    extern __shared__ __attribute__((aligned(16))) unsigned char lds[];
    Frame F;
    F.lds = (LAS unsigned char*)lds;
    F.tid = threadIdx.x; F.lane = F.tid & 63; F.wave = __builtin_amdgcn_readfirstlane(F.tid >> 6);
    F.G = gridDim.x; { const int bx = blockIdx.x; F.vcu = (F.G % 8 == 0) ? (bx % 8) * (F.G / 8) + bx / 8 : bx; }
    F.gw = F.vcu * 8 + F.wave; F.NGW = F.G * 8;
    unsigned char* ws = args.ws;
    F.x = args.in[0]; F.mem = args.in[1]; F.pre_norm = args.in[2]; F.w_in = args.in[3]; F.merge_bias = args.in[4]; F.na_rpb = args.in[5]; F.mem_norm = args.in[6];
    F.w_mem_kv = args.in[7]; F.w_br0 = args.in[8]; F.w_br1 = args.in[9]; F.w_br2 = args.in[10]; F.w_out = args.in[11]; F.post_norm = args.in[12];
    F.out = args.out; F.rope = (float*)(ws + WS_ROPE);
    F.Wt_in = (bf16_t*)(ws + WS_WIN); F.Wt_kv = (bf16_t*)(ws + WS_WKV); F.Wt_br = (bf16_t*)(ws + WS_WBR); F.Wt_out = (bf16_t*)(ws + WS_WOUT);
    F.XN = (bf16_t*)(ws + WS_XN); F.Y = (bf16_t*)(ws + WS_Y); F.MEMN = (bf16_t*)(ws + WS_MEMN); F.KVM = (bf16_t*)(ws + WS_KVM);
    F.QKVA = (bf16_t*)(ws + WS_QKVA); F.QKVB = (bf16_t*)(ws + WS_QKVB); F.QC = (bf16_t*)(ws + WS_QC); F.MG = (bf16_t*)(ws + WS_MG); F.U = (bf16_t*)args.out;
    volatile LAS unsigned* MISC = (volatile LAS unsigned*)(F.lds + MISC_OFF);
    for (int u = F.tid; u < (LDS_BYTES - 131072) / 4; u += 512) ((LAS unsigned*)(F.lds + 131072))[u] = 0u;
    __syncthreads();
    XcdBarrier bar; bar.bar = (unsigned*)(ws + WS_CTL) + CW_BAR; bar.x = 0; bar.st = nullptr;
    if (MK_N_LAUNCHES == 1) bar = xcd_barrier_post((unsigned*)(ws + WS_CTL) + CW_BAR, MISC + 8);
    const int lo = args.ph_lo, hi = args.ph_hi;
#define IN(k) (lo <= (k) && (k) < hi)
#define SEAM(k) do { if (IN(k) && IN((k) + 1)) xcd_barrier(bar); } while (0)

    if (IN(0)) { p0_prologue(F); } SEAM(0);
    if (IN(1)) {
        { pg8::Gemm g{F.XN, F.Wt_in, MTOK, N1, DM}; pg8::StaticOrder S; S.init(MTOK, N1, F.G, (int)blockIdx.x);
          pg8::EpiInP E{F.QKVA, F.U, F.QKVB, F.QC, F.MG, F.rope, F.merge_bias, 0};
          pg8::gemm_phase<pg8::EpiInP, pg8::StaticOrder, pg8::HookNone, true, true>(F.lds, g, S, E, pg8::HookNone{}); }
        { pg8::Gemm g{F.MEMN, F.Wt_kv, MMEM, DM, DM}; pg8::StaticOrder S; S.init(MMEM, DM, F.G, (int)blockIdx.x);
          pg8::EpiPlain E{F.KVM, DM};
          pg8::gemm_phase<pg8::EpiPlain, pg8::StaticOrder, pg8::HookNone, true, true>(F.lds, g, S, E, pg8::HookNone{}); }
    } SEAM(1);
    if (IN(2)) { attn_a_phase(F, (float*)(ws + WS_LSE)); } SEAM(2);
    if (IN(3)) { pg8::Gemm g{F.XN, F.Wt_in + (size_t)N1 * DM, MTOK, N2, DM}; pg8::StaticOrder S; S.init(MTOK, N2, F.G, (int)blockIdx.x);
          pg8::EpiInP E{F.QKVA, F.U, F.QKVB, F.QC, F.MG, F.rope, F.merge_bias, N1};
          pg8::gemm_phase<pg8::EpiInP, pg8::StaticOrder, pg8::HookNone, true, true>(F.lds, g, S, E, pg8::HookNone{}); } SEAM(3);
    if (IN(4)) { attn_bc_phase(F); } SEAM(4);
    if (IN(5)) { pg8::Gemm g{F.U, F.Wt_br, MTOK, DM, 1536}; pg8::StaticOrder S; S.init(MTOK, DM, F.G, (int)blockIdx.x);
          pg8::EpiY E{F.MG, F.Y}; pg8::HookGate H{F.MG};
          pg8::gemm_phase<pg8::EpiY, pg8::StaticOrder, pg8::HookGate, false, true>(F.lds, g, S, E, H); } SEAM(5);
    if (IN(6)) { EpiF32 E{F.out}; simple_gemm(F.Y, DM, F.Wt_out, DM, MTOK, DM, DM, F, E); } SEAM(6);
    if (IN(7)) { p5_rows(F); }
#undef IN
#undef SEAM
}

extern "C" void kernel_launch(void* const* d_in, const int* in_sizes, int n_in, void* d_out, int out_size, void* d_ws, size_t ws_size, hipStream_t stream) {
    static int grid = 0;
    if (grid == 0) {
        if (n_in != 13 || in_sizes[0] != MTOK * DM || out_size != MTOK * DM || ws_size < WS_END) { fprintf(stderr, "kernel_launch: unexpected shapes / workspace (n_in %d, ws %zu)\n", n_in, ws_size); grid = -1; return; }
        int dev = 0, cus = 0;
        if (hipGetDevice(&dev) != hipSuccess || hipDeviceGetAttribute(&cus, hipDeviceAttributeMultiprocessorCount, dev) != hipSuccess) { grid = -1; return; }
        if (hipFuncSetAttribute((const void*)fwd_kernel, hipFuncAttributeMaxDynamicSharedMemorySize, LDS_BYTES) != hipSuccess) { fprintf(stderr, "kernel_launch: hipFuncSetAttribute failed\n"); grid = -1; return; }
        (void)hipGetLastError();
        grid = cus;
    }
    if (grid < 0) return;
    (void)hipMemsetAsync((char*)d_ws + WS_CTL, 0, CTL_ZERO_BYTES, stream);
    Args a{};
    for (int i = 0; i < 13; ++i) a.in[i] = (const float*)d_in[i];
    a.out = (float*)d_out; a.ws = (unsigned char*)d_ws;
    for (int li = 0; li < MK_N_LAUNCHES; ++li) {
        if (MK_N_LAUNCHES == 1) { a.ph_lo = 0; a.ph_hi = N_PHASES; } else { a.ph_lo = li; a.ph_hi = li + 1; }
        a.li = li;
        hipLaunchKernelGGL(fwd_kernel, dim3(grid), dim3(512), LDS_BYTES, stream, a);
    }
}
```
